# Optimizing an MI355X kernel written in HIP

```python
import jax, jax.numpy as jnp
from jax import lax
import numpy as np

D_MODEL = 1024
BATCH = 32
SEQ = 2048
DEPTH = 2

GRID_W = 64
CTX_LEN = 256
HEAD_DIM = 64
N_HEADS_TOTAL = D_MODEL // HEAD_DIM
A_GROUPS = N_HEADS_TOTAL // 4
NA_HEADS = N_HEADS_TOTAL // 4
SW_Q_HEADS = N_HEADS_TOTAL - A_GROUPS - NA_HEADS
SW_KV_HEADS = max(1, SW_Q_HEADS // 4)
SW_GROUP = SW_Q_HEADS // SW_KV_HEADS
A_WIDTH = A_GROUPS * HEAD_DIM
NA_WIDTH = NA_HEADS * HEAD_DIM
SW_Q_WIDTH = SW_Q_HEADS * HEAD_DIM
SW_KV_WIDTH = SW_KV_HEADS * HEAD_DIM
MIX_WIDTH = A_WIDTH + NA_WIDTH + SW_Q_WIDTH
PROJ_WIDTHS = (A_WIDTH, A_WIDTH, NA_WIDTH, NA_WIDTH, NA_WIDTH, SW_Q_WIDTH, SW_KV_WIDTH, SW_KV_WIDTH)
IN_WIDTH = sum(PROJ_WIDTHS)
CHUNK = 128
NA_ROWS = 8
NA_COLS = 16
SW_WINDOW = 128
SW_BLOCK = 128
ROPE_BASE = 10000.0
ROPE_HALF = HEAD_DIM // 2
ROPE_FREQS = ROPE_HALF // 2
D_FF = 4 * D_MODEL
DEEPNORM_ALPHA = (2 * DEPTH) ** 0.25
DEEPNORM_BETA = (8 * DEPTH) ** -0.25
LN_EPS = 1e-5
NEG_INF = -1e30

kernel_name = 'hybrid_parallel_heads_diffusion_trunk'


def layer_norm(x, g, b):
    xf = x.astype(jnp.float32)
    mu = jnp.mean(xf, axis=-1, keepdims=True)
    var = jnp.mean(jnp.square(xf - mu), axis=-1, keepdims=True)
    return ((xf - mu) * lax.rsqrt(var + LN_EPS)).astype(x.dtype) * g + b


def modulate(x, shift, scale):
    return x * (1.0 + scale) + shift


def post_norm_residual(x, y, g, b):
    return layer_norm(DEEPNORM_ALPHA * x + y, g, b)


def split_projection(p):
    idx = [int(i) for i in np.cumsum(PROJ_WIDTHS)[:-1]]
    return jnp.split(p, idx, axis=-1)


def to_heads(t, n):
    b, l, _ = t.shape
    return t.reshape(b, l, n, HEAD_DIM).transpose(0, 2, 1, 3)


def to_gqa_q(t):
    b, l, _ = t.shape
    return t.reshape(b, l, SW_KV_HEADS, SW_GROUP, HEAD_DIM).transpose(0, 2, 3, 1, 4)


def merge_heads(t):
    b, h, l, d = t.shape
    return t.transpose(0, 2, 1, 3).reshape(b, l, h * d)


def merge_gqa(t):
    b, kv, g, l, d = t.shape
    return t.transpose(0, 3, 1, 2, 4).reshape(b, l, kv * g * d)


def _rotate(t, ang):
    t1, t2 = jnp.split(t, 2, axis=-1)
    cos, sin = jnp.cos(ang), jnp.sin(ang)
    return jnp.concatenate([t1 * cos - t2 * sin, t1 * sin + t2 * cos], axis=-1)


def axial_rope(t, row_pos, col_pos):
    inv_freq = ROPE_BASE ** (-jnp.arange(ROPE_FREQS, dtype=jnp.float32) / ROPE_FREQS)
    ang_r = row_pos.astype(jnp.float32)[:, None] * inv_freq
    ang_c = col_pos.astype(jnp.float32)[:, None] * inv_freq
    tf = t.astype(jnp.float32)
    out = jnp.concatenate([_rotate(tf[..., :ROPE_HALF], ang_r), _rotate(tf[..., ROPE_HALF:], ang_c)], axis=-1)
    return out.astype(t.dtype)


def attn_probs(scores, sink=None):
    parts = [s.astype(jnp.float32) for s in scores]
    if sink is not None:
        parts.append(jnp.broadcast_to(sink.astype(jnp.float32), parts[0].shape[:-1] + (1,)))
    p = jax.nn.softmax(jnp.concatenate(parts, axis=-1), axis=-1)
    sizes = [s.shape[-1] for s in scores]
    idx = [int(i) for i in np.cumsum(sizes)[:-1]]
    return jnp.split(p[..., :sum(sizes)], idx, axis=-1)


def gmlp_chunk_mix(u, v, ln_g, ln_b, w_s, b_s):
    b, l, _ = v.shape
    v = layer_norm(v, ln_g, ln_b).reshape(b, l // CHUNK, CHUNK, A_GROUPS, HEAD_DIM)
    mixed = jnp.einsum('gij,bnjgc->bnigc', w_s, v) + b_s.T[None, None, :, :, None]
    return u * mixed.reshape(b, l, A_WIDTH)


def ctx_self_attention(q, k, v, sink):
    s = jnp.einsum('bkgqd,bkcd->bkgqc', q, k) * (HEAD_DIM ** -0.5)
    (p,) = attn_probs([s], sink)
    return jnp.einsum('bkgqc,bkcd->bkgqd', p.astype(v.dtype), v)


def neighbourhood_attention(q, k, v, kc, vc, rpb):
    b, h, s, d = q.shape
    rows = s // GRID_W
    win_r = min(NA_ROWS, rows)
    qg = q.reshape(b, h, rows, GRID_W, d)
    kg = k.reshape(b, h, rows, GRID_W, d)
    vg = v.reshape(b, h, rows, GRID_W, d)
    cq = jnp.arange(GRID_W)
    cs = jnp.clip(cq - NA_COLS // 2, 0, GRID_W - NA_COLS)
    col_ok = (cq[None, :] >= cs[:, None]) & (cq[None, :] < cs[:, None] + NA_COLS)
    dc = jnp.clip(cq[None, :] - cq[:, None], -(NA_COLS - 1), NA_COLS - 1) + NA_COLS - 1
    rpb_col = rpb[:, :, dc]
    mask = jnp.tile(col_ok, (1, win_r))
    scale = HEAD_DIM ** -0.5

    def one_row(args):
        q_r, r = args
        rs = jnp.clip(r - win_r // 2, 0, rows - win_r)
        k_r = lax.dynamic_slice_in_dim(kg, rs, win_r, axis=2).reshape(b, h, win_r * GRID_W, d)
        v_r = lax.dynamic_slice_in_dim(vg, rs, win_r, axis=2).reshape(b, h, win_r * GRID_W, d)
        dr = rs + jnp.arange(win_r) - r + NA_ROWS - 1
        bias = jnp.take(rpb_col, dr, axis=1).transpose(0, 2, 1, 3).reshape(h, GRID_W, win_r * GRID_W)
        s_loc = jnp.einsum('bhqd,bhkd->bhqk', q_r, k_r).astype(jnp.float32) * scale + bias.astype(jnp.float32)
        s_loc = jnp.where(mask, s_loc, NEG_INF)
        s_ctx = jnp.einsum('bhqd,bhcd->bhqc', q_r, kc) * scale
        p_loc, p_ctx = attn_probs([s_loc, s_ctx])
        return (jnp.einsum('bhqk,bhkd->bhqd', p_loc.astype(v.dtype), v_r)
                + jnp.einsum('bhqc,bhcd->bhqd', p_ctx.astype(v.dtype), vc))

    out = lax.map(one_row, (jnp.moveaxis(qg, 2, 0), jnp.arange(rows)))
    return jnp.moveaxis(out, 0, 2).reshape(b, h, s, d)


def sliding_window_attention(q, k, v, kc, vc, sink):
    b, kv, g, s, d = q.shape
    nb = s // SW_BLOCK
    pad = ((0, 0), (0, 0), (SW_BLOCK, SW_BLOCK), (0, 0))
    kp = jnp.pad(k, pad).reshape(b, kv, nb + 2, SW_BLOCK, d)
    vp = jnp.pad(v, pad).reshape(b, kv, nb + 2, SW_BLOCK, d)
    band = lambda t: jnp.concatenate([t[:, :, :-2], t[:, :, 1:-1], t[:, :, 2:]], axis=3)
    kb, vb = band(kp), band(vp)
    qb = q.reshape(b, kv, g, nb, SW_BLOCK, d)
    k_rel = jnp.arange(3 * SW_BLOCK) - SW_BLOCK
    band_ok = jnp.abs(k_rel[None, :] - jnp.arange(SW_BLOCK)[:, None]) <= SW_WINDOW
    scale = HEAD_DIM ** -0.5

    def one_block(args):
        q_i, k_i, v_i, i = args
        k_abs = i * SW_BLOCK + k_rel
        ok = band_ok & ((k_abs >= 0) & (k_abs < s))[None, :]
        s_loc = jnp.einsum('bkgqd,bknd->bkgqn', q_i, k_i).astype(jnp.float32) * scale
        s_loc = jnp.where(ok, s_loc, NEG_INF)
        s_ctx = jnp.einsum('bkgqd,bkcd->bkgqc', q_i, kc) * scale
        p_loc, p_ctx = attn_probs([s_loc, s_ctx], sink)
        return (jnp.einsum('bkgqn,bknd->bkgqd', p_loc.astype(v.dtype), v_i)
                + jnp.einsum('bkgqc,bkcd->bkgqd', p_ctx.astype(v.dtype), vc))

    out = lax.map(one_block, (jnp.moveaxis(qb, 3, 0), jnp.moveaxis(kb, 2, 0), jnp.moveaxis(vb, 2, 0), jnp.arange(nb)))
    return jnp.moveaxis(out, 0, 3).reshape(b, kv, g, s, d)


def squared_relu_mlp(h, w1, w2):
    return jnp.square(jax.nn.relu(h @ w1)) @ w2


def trunk_layer(x, xc, c, c_ctx, w_mod, b_mod, w_in, a_ln_g, a_ln_b, a_ws, a_bs, na_rpb, sw_sink,
                w_out, ln1_g, ln1_b, w1, w2, ln2_g, ln2_b, update_ctx):
    s = x.shape[1]
    pos = jnp.arange(s)
    row_pos, col_pos = pos // GRID_W, pos % GRID_W
    mod = jax.nn.silu(c) @ w_mod + b_mod
    mod_c = jax.nn.silu(c_ctx)[None] @ w_mod + b_mod
    sh1, sc1, g1, sh2, sc2, g2 = [m[:, None, :] for m in jnp.split(mod, 6, axis=-1)]
    sh1c, sc1c, g1c, sh2c, sc2c, g2c = [m[:, None, :] for m in jnp.split(mod_c, 6, axis=-1)]

    a_u, a_v, na_q, na_k, na_v, sw_q, sw_k, sw_v = split_projection(modulate(x, sh1, sc1) @ w_in)
    ca_u, ca_v, cna_q, cna_k, cna_v, csw_q, csw_k, csw_v = split_projection(modulate(xc, sh1c, sc1c) @ w_in)
    sink = sw_sink.reshape(SW_KV_HEADS, SW_GROUP)[None, :, :, None, None]

    kc_na, vc_na = to_heads(cna_k, NA_HEADS), to_heads(cna_v, NA_HEADS)
    kc_sw, vc_sw = to_heads(csw_k, SW_KV_HEADS), to_heads(csw_v, SW_KV_HEADS)

    y_a = gmlp_chunk_mix(jax.nn.gelu(a_u), jax.nn.gelu(a_v), a_ln_g, a_ln_b, a_ws, a_bs)
    y_na = neighbourhood_attention(to_heads(na_q, NA_HEADS), to_heads(na_k, NA_HEADS), to_heads(na_v, NA_HEADS),
                                   kc_na, vc_na, na_rpb)
    q_sw = axial_rope(to_gqa_q(sw_q), row_pos, col_pos)
    k_sw = axial_rope(to_heads(sw_k, SW_KV_HEADS), row_pos, col_pos)
    y_sw = sliding_window_attention(q_sw, k_sw, to_heads(sw_v, SW_KV_HEADS), kc_sw, vc_sw, sink)
    y = jnp.concatenate([y_a, merge_heads(y_na), merge_gqa(y_sw)], axis=-1) @ w_out
    x_new = post_norm_residual(x, g1 * y, ln1_g, ln1_b)
    x_new = post_norm_residual(x_new, g2 * squared_relu_mlp(modulate(x_new, sh2, sc2), w1, w2), ln2_g, ln2_b)

    if update_ctx:
        yc_a = gmlp_chunk_mix(jax.nn.gelu(ca_u), jax.nn.gelu(ca_v), a_ln_g, a_ln_b, a_ws, a_bs)
        yc_na = ctx_self_attention(to_heads(cna_q, NA_HEADS)[:, :, None], kc_na, vc_na, None)[:, :, 0]
        yc_sw = ctx_self_attention(to_gqa_q(csw_q), kc_sw, vc_sw, sink)
        yc = jnp.concatenate([yc_a, merge_heads(yc_na), merge_gqa(yc_sw)], axis=-1) @ w_out
        xc = post_norm_residual(xc, g1c * yc, ln1_g, ln1_b)
        xc = post_norm_residual(xc, g2c * squared_relu_mlp(modulate(xc, sh2c, sc2c), w1, w2), ln2_g, ln2_b)
    return x_new, xc


def setup_inputs(seed: int = 0) -> dict:
    key = jax.random.key(seed)
    ks = jax.random.split(key, 20)
    n = lambda k, shape: jax.random.normal(k, shape, jnp.float32)
    return {
        'x': n(ks[0], (BATCH, SEQ, D_MODEL)),
        'c': n(ks[1], (BATCH, D_MODEL)),
        'ctx': n(ks[2], (BATCH, CTX_LEN, D_MODEL)),
        'c_ctx': n(ks[3], (D_MODEL,)),
        'w_mod': n(ks[4], (DEPTH, D_MODEL, 6 * D_MODEL)) * D_MODEL ** -0.5,
        'b_mod': n(ks[5], (DEPTH, 6 * D_MODEL)) * 0.02,
        'w_in': n(ks[6], (DEPTH, D_MODEL, IN_WIDTH)) * D_MODEL ** -0.5,
        'a_ln_g': 1.0 + 0.02 * n(ks[7], (DEPTH, A_WIDTH)),
        'a_ln_b': 0.02 * n(ks[8], (DEPTH, A_WIDTH)),
        'a_ws': n(ks[9], (DEPTH, A_GROUPS, CHUNK, CHUNK)) * CHUNK ** -0.5,
        'a_bs': 1.0 + 0.02 * n(ks[10], (DEPTH, A_GROUPS, CHUNK)),
        'na_rpb': 0.1 * n(ks[11], (DEPTH, NA_HEADS, 2 * NA_ROWS - 1, 2 * NA_COLS - 1)),
        'sw_sink': n(ks[12], (DEPTH, SW_Q_HEADS)),
        'w_out': n(ks[13], (DEPTH, MIX_WIDTH, D_MODEL)) * (MIX_WIDTH ** -0.5 * DEEPNORM_BETA),
        'ln1_g': 1.0 + 0.02 * n(ks[14], (DEPTH, D_MODEL)),
        'ln1_b': 0.02 * n(ks[15], (DEPTH, D_MODEL)),
        'w1': n(ks[16], (DEPTH, D_MODEL, D_FF)) * D_MODEL ** -0.5,
        'w2': n(ks[17], (DEPTH, D_FF, D_MODEL)) * (D_FF ** -0.5 * DEEPNORM_BETA),
        'ln2_g': 1.0 + 0.02 * n(ks[18], (DEPTH, D_MODEL)),
        'ln2_b': 0.02 * n(ks[19], (DEPTH, D_MODEL)),
    }


def reference(x, c, ctx, c_ctx, w_mod, b_mod, w_in, a_ln_g, a_ln_b, a_ws, a_bs, na_rpb, sw_sink,
              w_out, ln1_g, ln1_b, w1, w2, ln2_g, ln2_b):
    xc = ctx
    for layer in range(DEPTH):
        x, xc = trunk_layer(x, xc, c, c_ctx, w_mod[layer], b_mod[layer], w_in[layer], a_ln_g[layer], a_ln_b[layer],
                            a_ws[layer], a_bs[layer], na_rpb[layer], sw_sink[layer], w_out[layer],
                            ln1_g[layer], ln1_b[layer], w1[layer], w2[layer], ln2_g[layer], ln2_b[layer],
                            update_ctx=layer < DEPTH - 1)
    return x
```

```cpp
#include <hip/hip_runtime.h>
#include <hip/hip_cooperative_groups.h>
#include <cstdio>
#include <cstdint>
namespace cg = cooperative_groups;

typedef unsigned short bf16_t;
typedef short bf16x8 __attribute__((ext_vector_type(8)));
typedef short bf16x4 __attribute__((ext_vector_type(4)));
typedef float f32x4 __attribute__((ext_vector_type(4)));
typedef unsigned u32x2 __attribute__((ext_vector_type(2)));
typedef unsigned u32x4 __attribute__((ext_vector_type(4)));
#define LAS __attribute__((address_space(3)))

constexpr int DM = 1024, NB = 32, SEQ = 2048, CTXL = 256, TL = NB * SEQ, TC = NB * CTXL, TT = TL + TC, DFF = 4096, INW = 2048;
constexpr int NTHREADS = 512, NWAVES = 8;
constexpr int LDS_BYTES = 136 * 1024;
constexpr float ALPHA = 1.41421356237f;
constexpr float LOG2E = 1.4426950408889634f;

constexpr size_t OFF_WIN = 0;
constexpr size_t OFF_WOUT = OFF_WIN + 2ull * 2048 * 1024 * 2;
constexpr size_t OFF_W1 = OFF_WOUT + 2ull * 1024 * 1024 * 2;
constexpr size_t OFF_W2 = OFF_W1 + 2ull * 4096 * 1024 * 2;
constexpr size_t OFF_AWS = OFF_W2 + 2ull * 4096 * 1024 * 2;
constexpr size_t OFF_MOD = OFF_AWS + 2ull * 4 * 128 * 128 * 2;
constexpr size_t OFF_ROPE = OFF_MOD + 2ull * 33 * 6144 * 4;
constexpr size_t OFF_BAR = OFF_ROPE + 8192;
constexpr size_t OFF_XZ = OFF_BAR + 256;
constexpr size_t OFF_U = OFF_XZ + (size_t)TT * 1024 * 4;
constexpr size_t WS_END = OFF_U + (size_t)TT * 4096 * 2;
constexpr size_t OFF_P = OFF_U;
constexpr size_t OFF_Y = OFF_P + (size_t)TT * 2048 * 2;
constexpr size_t OFF_VTNA_L = OFF_Y + (size_t)TT * 1024 * 2;
constexpr size_t OFF_VTNA_C = OFF_VTNA_L + (size_t)NB * 4 * 64 * 2048 * 2;
constexpr size_t OFF_VTSW_L = OFF_VTNA_C + (size_t)NB * 4 * 64 * 256 * 2;
constexpr size_t OFF_VTSW_C = OFF_VTSW_L + (size_t)NB * 2 * 64 * 2048 * 2;
static_assert(OFF_VTSW_C + (size_t)NB * 2 * 64 * 256 * 2 <= WS_END, "overlay");

struct Params {
    const float *x, *c, *ctx, *c_ctx, *w_mod, *b_mod, *w_in, *a_ln_g, *a_ln_b, *a_ws, *a_bs, *na_rpb, *sw_sink, *w_out, *ln1_g, *ln1_b, *w1, *w2, *ln2_g, *ln2_b;
    float* out;
    unsigned char* ws;
};

typedef float f32x2 __attribute__((ext_vector_type(2)));
typedef __bf16 bf16v2 __attribute__((ext_vector_type(2)));
__device__ __forceinline__ unsigned cvt_pk_bf16(float lo, float hi) { f32x2 v = {lo, hi}; bf16v2 r = __builtin_convertvector(v, bf16v2); return __builtin_bit_cast(unsigned, r); }
__device__ __forceinline__ float bf2f(unsigned short v) { return __uint_as_float(((unsigned)v) << 16); }
__device__ __forceinline__ float bflo(unsigned v) { return __uint_as_float(v << 16); }
__device__ __forceinline__ float bfhi(unsigned v) { return __uint_as_float(v & 0xffff0000u); }
__device__ __forceinline__ float fexp2(float v) { return __builtin_amdgcn_exp2f(v); }
__device__ __forceinline__ int tid_opaque() { int t = threadIdx.x; asm volatile("" : "+v"(t)); return t; }

__device__ __forceinline__ int lds_off(int r, int c) { return r * 128 + ((c ^ ((r >> 1) & 7)) << 4); }

template <class Epi, bool NRM>
__device__ __forceinline__ void gemm_unit(LAS unsigned char* lds, const bf16_t* __restrict__ uA, const bf16_t* __restrict__ uB, unsigned voff, int K, int nt, const Epi& epi, int pm, int pn, int wr, int wc, int fr, int fq, int wid) {
    f32x4 acc[8][4];
#pragma unroll
    for (int m = 0; m < 8; ++m)
#pragma unroll
        for (int n = 0; n < 4; ++n) acc[m][n] = (f32x4){0.f, 0.f, 0.f, 0.f};
#define GEMM_STAGE(buf, kt_) do { _Pragma("unroll") for (int i_ = 0; i_ < 4; ++i_) { \
        __builtin_amdgcn_global_load_lds((const unsigned*)((const char*)(uA + (size_t)i_ * 64 * K + (size_t)(kt_) * 64) + voff), (LAS unsigned*)(lds + (buf) * 65536 + wid * 1024 + i_ * 8192), 16, 0, 0); \
        __builtin_amdgcn_global_load_lds((const unsigned*)((const char*)(uB + (size_t)i_ * 64 * K + (size_t)(kt_) * 64) + voff), (LAS unsigned*)(lds + (buf) * 65536 + 32768 + wid * 1024 + i_ * 8192), 16, 0, 0); } } while (0)
    GEMM_STAGE(0, 0);
    asm volatile("s_waitcnt vmcnt(0)" ::: "memory");
    __syncthreads();
    for (int kt = 0; kt < nt; ++kt) {
        const int cur = kt & 1;
        if (kt + 1 < nt) GEMM_STAGE(cur ^ 1, kt + 1);
        const LAS unsigned char* la = lds + cur * 65536;
        const LAS unsigned char* lb = la + 32768;
#pragma unroll
        for (int kk = 0; kk < 2; ++kk) {
            bf16x8 bfr[4];
#pragma unroll
            for (int n = 0; n < 4; ++n) bfr[n] = *(const LAS bf16x8*)(lb + lds_off(wc * 64 + n * 16 + fr, kk * 4 + fq));
#pragma unroll
            for (int mh = 0; mh < 2; ++mh) {
                bf16x8 af[4];
#pragma unroll
                for (int m = 0; m < 4; ++m) af[m] = *(const LAS bf16x8*)(la + lds_off(wr * 128 + (mh * 4 + m) * 16 + fr, kk * 4 + fq));
#pragma unroll
                for (int m = 0; m < 4; ++m)
#pragma unroll
                    for (int n = 0; n < 4; ++n) {
                        if (NRM) acc[mh * 4 + m][n] = __builtin_amdgcn_mfma_f32_16x16x32_bf16(af[m], bfr[n], acc[mh * 4 + m][n], 0, 0, 0);
                        else acc[mh * 4 + m][n] = __builtin_amdgcn_mfma_f32_16x16x32_bf16(bfr[n], af[m], acc[mh * 4 + m][n], 0, 0, 0);
                    }
            }
        }
        asm volatile("s_waitcnt vmcnt(0)" ::: "memory");
        __syncthreads();
    }
#undef GEMM_STAGE
    epi.template run<NRM>(acc, pm, pn, wr, wc, fr, fq);
}

template <class Epi>
__device__ __forceinline__ void gemm_phase(LAS unsigned char* lds, const bf16_t* __restrict__ A, const bf16_t* __restrict__ Bt, int M, int N, int K, const Epi& epi) {
    const int tid = tid_opaque(), wid = __builtin_amdgcn_readfirstlane(tid >> 6), lane = tid & 63, wr = wid >> 2, wc = wid & 3, fr = lane & 15, fq = lane >> 4;
    const int nN = N >> 8, total = (M >> 8) * nN, nt = K >> 6;
    const int sr = tid >> 3;
    const unsigned voff = (unsigned)(sr * K + (((lane & 7) ^ ((sr >> 1) & 7)) << 3)) * 2u;
    for (int u = blockIdx.x; u < total; u += gridDim.x) {
        const int pm = u / nN, pn = u - pm * nN;
        const bf16_t* uA = A + (size_t)(pm * 256) * K;
        const bf16_t* uB = Bt + (size_t)(pn * 256) * K;
        if (Epi::HAS_NORMAL && Epi::normal(pn, wc)) gemm_unit<Epi, true>(lds, uA, uB, voff, K, nt, epi, pm, pn, wr, wc, fr, fq, wid);
        else gemm_unit<Epi, false>(lds, uA, uB, voff, K, nt, epi, pm, pn, wr, wc, fr, fq, wid);
    }
}

__device__ __forceinline__ float gelu_tanh(float v) {
    const float u = 0.7978845608028654f * (v + 0.044715f * v * v * v);
    return v / (1.0f + __expf(-2.0f * u));
}

struct EpiIn {
    bf16_t* P; unsigned char* ws; const float* rcos; const float* rsin;
    static constexpr bool HAS_NORMAL = true;
    __device__ static __forceinline__ bool normal(int pn, int wc) { const int cb = pn * 256 + wc * 64; return (cb >= 1024 && cb < 1280) || cb >= 1920; }
    template <bool NRM> __device__ __forceinline__ void run(f32x4 (&acc)[8][4], int pm, int pn, int wr, int wc, int fr, int fq) const {
        const int cb = pn * 256 + wc * 64, row0 = pm * 256 + wr * 128;
        if (NRM) {
            const bool isna = cb < 1280; const int head = isna ? ((cb - 1024) >> 6) : ((cb - 1920) >> 6); const int nh = isna ? 4 : 2;
            const bool latr = row0 < TL;
            const int b = latr ? (row0 >> 11) : ((row0 - TL) >> 8), s0 = latr ? (row0 & 2047) : ((row0 - TL) & 255), stride = latr ? 2048 : 256;
            const size_t off = latr ? (isna ? OFF_VTNA_L : OFF_VTSW_L) : (isna ? OFF_VTNA_C : OFF_VTSW_C);
            bf16_t* base = (bf16_t*)(ws + off) + (size_t)((b * nh + head) * 64) * stride + s0;
#pragma unroll
            for (int m = 0; m < 8; ++m)
#pragma unroll
                for (int n = 0; n < 4; ++n) {
                    u32x2 w; w.x = cvt_pk_bf16(acc[m][n][0], acc[m][n][1]); w.y = cvt_pk_bf16(acc[m][n][2], acc[m][n][3]);
                    *(u32x2*)(base + (size_t)(n * 16 + fr) * stride + m * 16 + fq * 4) = w;
                }
            return;
        }
        const bool lat = row0 < TL;
        const int emode = cb < 512 ? 1 : ((cb >= 1280 && lat) ? 2 : 0);
        const float sc = ((cb >= 512 && cb < 768) || (cb >= 1280 && cb < 1792)) ? 0.125f : 1.0f;
        bf16_t* rowp = P + (size_t)(row0 + fr) * 2048 + cb + 4 * fq;
        int row = row0 + fr; asm volatile("" : "+v"(row));
#pragma unroll
        for (int m = 0; m < 8; ++m) {
            f32x4 v0 = acc[m][0], v1 = acc[m][1], v2 = acc[m][2], v3 = acc[m][3];
            if (emode == 1) {
#pragma unroll
                for (int j = 0; j < 4; ++j) { v0[j] = gelu_tanh(v0[j]); v1[j] = gelu_tanh(v1[j]); v2[j] = gelu_tanh(v2[j]); v3[j] = gelu_tanh(v3[j]); }
            } else if (emode == 2) {
                const int s = row & 2047; const int rp = s >> 6, cp = s & 63;
                const f32x4 c0 = *(const f32x4*)(rcos + rp * 16 + 4 * fq), s0 = *(const f32x4*)(rsin + rp * 16 + 4 * fq);
                const f32x4 c1 = *(const f32x4*)(rcos + cp * 16 + 4 * fq), s1 = *(const f32x4*)(rsin + cp * 16 + 4 * fq);
                const f32x4 a0 = v0, a1 = v1, a2 = v2, a3 = v3;
                v0 = a0 * c0 - a1 * s0; v1 = a0 * s0 + a1 * c0;
                v2 = a2 * c1 - a3 * s1; v3 = a2 * s1 + a3 * c1;
            }
            u32x2 w;
            w.x = cvt_pk_bf16(v0[0] * sc, v0[1] * sc); w.y = cvt_pk_bf16(v0[2] * sc, v0[3] * sc); *(u32x2*)(rowp) = w;
            w.x = cvt_pk_bf16(v1[0] * sc, v1[1] * sc); w.y = cvt_pk_bf16(v1[2] * sc, v1[3] * sc); *(u32x2*)(rowp + 16) = w;
            w.x = cvt_pk_bf16(v2[0] * sc, v2[1] * sc); w.y = cvt_pk_bf16(v2[2] * sc, v2[3] * sc); *(u32x2*)(rowp + 32) = w;
            w.x = cvt_pk_bf16(v3[0] * sc, v3[1] * sc); w.y = cvt_pk_bf16(v3[2] * sc, v3[3] * sc); *(u32x2*)(rowp + 48) = w;
            rowp += 16 * 2048; row += 16;
            asm volatile("" : "+v"(rowp), "+v"(row) :: "memory");
        }
    }
};

struct EpiRes {
    const float* res_lat; const float* res_ctx; const float* g; float* out;
    static constexpr bool HAS_NORMAL = false;
    __device__ static __forceinline__ bool normal(int, int) { return false; }
    template <bool NRM> __device__ __forceinline__ void run(f32x4 (&acc)[8][4], int pm, int pn, int wr, int wc, int fr, int fq) const {
        const int row0 = pm * 256 + wr * 128, cb = pn * 256 + wc * 64 + 4 * fq;
        const int mr = row0 < TL ? (row0 >> 11) : 32;
        const float* gp = g + (size_t)mr * 6144 + cb;
        f32x4 gg[4];
#pragma unroll
        for (int n = 0; n < 4; ++n) gg[n] = *(const f32x4*)(gp + n * 16);
#pragma unroll
        for (int m = 0; m < 8; ++m) {
            const int row = row0 + m * 16 + fr;
            const float* rp = (row < TL ? res_lat + (size_t)row * 1024 : res_ctx + (size_t)(row - TL) * 1024) + cb;
            float* op = out + (size_t)row * 1024 + cb;
#pragma unroll
            for (int n = 0; n < 4; ++n) { const f32x4 r = *(const f32x4*)(rp + n * 16); const f32x4 z = r * ALPHA + gg[n] * acc[m][n]; *(f32x4*)(op + n * 16) = z; }
        }
    }
};

struct EpiRelu2 {
    bf16_t* U;
    static constexpr bool HAS_NORMAL = false;
    __device__ static __forceinline__ bool normal(int, int) { return false; }
    template <bool NRM> __device__ __forceinline__ void run(f32x4 (&acc)[8][4], int pm, int pn, int wr, int wc, int fr, int fq) const {
        const int row0 = pm * 256 + wr * 128, cb = pn * 256 + wc * 64 + 4 * fq;
#pragma unroll
        for (int m = 0; m < 8; ++m) {
            bf16_t* rowp = U + (size_t)(row0 + m * 16 + fr) * 4096 + cb;
#pragma unroll
            for (int n = 0; n < 4; ++n) {
                f32x4 v = acc[m][n];
#pragma unroll
                for (int j = 0; j < 4; ++j) { const float t = fmaxf(v[j], 0.f); v[j] = t * t; }
                u32x2 w; w.x = cvt_pk_bf16(v[0], v[1]); w.y = cvt_pk_bf16(v[2], v[3]);
                *(u32x2*)(rowp + n * 16) = w;
            }
        }
    }
};

__device__ __forceinline__ void transpose_tile(const float* __restrict__ src, bf16_t* __restrict__ dst, int K, int N, int kb, int nb, LAS float* lt) {
    const int tid = tid_opaque();
    { const int n = tid & 63, k0 = tid >> 6;
#pragma unroll
      for (int i = 0; i < 8; ++i) { const int k = k0 + 8 * i; lt[k * 65 + n] = src[(size_t)(kb + k) * N + nb + n]; } }
    __syncthreads();
    { const int kp = tid & 31, n0 = tid >> 5;
#pragma unroll
      for (int i = 0; i < 4; ++i) { const int n = n0 + 16 * i; const unsigned w = cvt_pk_bf16(lt[(2 * kp) * 65 + n], lt[(2 * kp + 1) * 65 + n]); *(unsigned*)(dst + (size_t)(nb + n) * K + kb + 2 * kp) = w; } }
    __syncthreads();
}

__device__ void phase_prologue(const Params& p, LAS unsigned char* lds) {
    const int tid = tid_opaque();
    LAS float* lf = (LAS float*)lds;
    for (int u = blockIdx.x; u < 192; u += gridDim.x) {
        const int l = u / 96, nb = (u % 96) * 64;
        for (int idx = tid; idx < 33 * 1024; idx += NTHREADS) { const int r = idx >> 10, k = idx & 1023; const float v = r < 32 ? p.c[r * 1024 + k] : p.c_ctx[k]; lf[idx] = v / (1.0f + __expf(-v)); }
        __syncthreads();
        const int n = tid & 63, s = __builtin_amdgcn_readfirstlane(tid >> 6);
        float acc[33];
#pragma unroll
        for (int r = 0; r < 33; ++r) acc[r] = 0.f;
        const float* wp = p.w_mod + ((size_t)l * 1024 + s * 128) * 6144 + nb + n;
        for (int k = 0; k < 128; ++k) {
            const float w = wp[(size_t)k * 6144];
            const LAS float* sp = lf + s * 128 + k;
#pragma unroll
            for (int r = 0; r < 33; ++r) acc[r] += sp[r * 1024] * w;
        }
        __syncthreads();
#pragma unroll
        for (int r = 0; r < 33; ++r) lf[(s * 33 + r) * 64 + n] = acc[r];
        __syncthreads();
        for (int idx = tid; idx < 33 * 64; idx += NTHREADS) {
            const int r = idx >> 6, nn = idx & 63; float sum = p.b_mod[l * 6144 + nb + nn];
#pragma unroll
            for (int ss = 0; ss < 8; ++ss) sum += lf[(ss * 33 + r) * 64 + nn];
            ((float*)(p.ws + OFF_MOD))[((size_t)l * 33 + r) * 6144 + nb + nn] = sum;
        }
        __syncthreads();
    }
    for (int u = blockIdx.x; u < 2 * 2816; u += gridDim.x) {
        const int l = u / 2816; int r = u % 2816;
        if (r < 512) { const int kb = (r >> 5) * 64, nb = (r & 31) * 64; transpose_tile(p.w_in + (size_t)l * 1024 * 2048, (bf16_t*)(p.ws + OFF_WIN) + (size_t)l * 2048 * 1024, 1024, 2048, kb, nb, lf); }
        else if (r < 768) { r -= 512; const int kb = (r >> 4) * 64, nb = (r & 15) * 64; transpose_tile(p.w_out + (size_t)l * 1024 * 1024, (bf16_t*)(p.ws + OFF_WOUT) + (size_t)l * 1024 * 1024, 1024, 1024, kb, nb, lf); }
        else if (r < 1792) { r -= 768; const int kb = (r >> 6) * 64, nb = (r & 63) * 64; transpose_tile(p.w1 + (size_t)l * 1024 * 4096, (bf16_t*)(p.ws + OFF_W1) + (size_t)l * 4096 * 1024, 1024, 4096, kb, nb, lf); }
        else { r -= 1792; const int kb = (r >> 4) * 64, nb = (r & 15) * 64; transpose_tile(p.w2 + (size_t)l * 4096 * 1024, (bf16_t*)(p.ws + OFF_W2) + (size_t)l * 1024 * 4096, 4096, 1024, kb, nb, lf); }
    }
    const int gt = blockIdx.x * NTHREADS + tid, gn = gridDim.x * NTHREADS;
    for (int i = gt; i < 2 * 4 * 128 * 128 / 2; i += gn) { ((unsigned*)(p.ws + OFF_AWS))[i] = cvt_pk_bf16(p.a_ws[2 * i], p.a_ws[2 * i + 1]); }
    for (int i = gt; i < 1024; i += gn) {
        const int pos = i >> 4, f = i & 15; const float inv = powf(10000.0f, -(float)f / 16.0f); const float ang = (float)pos * inv;
        ((float*)(p.ws + OFF_ROPE))[i] = cosf(ang); ((float*)(p.ws + OFF_ROPE))[1024 + i] = sinf(ang);
    }
}

__device__ void phase_modulate0(const Params& p, bf16_t* H) {
    const float* mod = (const float*)(p.ws + OFF_MOD);
    const size_t total = (size_t)TT * 128, gn = (size_t)gridDim.x * NTHREADS;
    for (size_t i = (size_t)blockIdx.x * NTHREADS + tid_opaque(); i < total; i += gn) {
        const int row = (int)(i >> 7), c8 = (int)(i & 127) * 8;
        const float* src = (row < TL ? p.x + (size_t)row * 1024 : p.ctx + (size_t)(row - TL) * 1024) + c8;
        const int mr = row < TL ? (row >> 11) : 32;
        const float* sh = mod + (size_t)mr * 6144 + c8; const float* sc = sh + 1024;
        const f32x4 a = *(const f32x4*)src, b = *(const f32x4*)(src + 4);
        const f32x4 sa = *(const f32x4*)sh, sb = *(const f32x4*)(sh + 4), ca = *(const f32x4*)sc, cb = *(const f32x4*)(sc + 4);
        const f32x4 ya = a * (ca + 1.0f) + sa, yb = b * (cb + 1.0f) + sb;
        u32x4 w; w.x = cvt_pk_bf16(ya[0], ya[1]); w.y = cvt_pk_bf16(ya[2], ya[3]); w.z = cvt_pk_bf16(yb[0], yb[1]); w.w = cvt_pk_bf16(yb[2], yb[3]);
        *(u32x4*)(H + (size_t)row * 1024 + c8) = w;
    }
}

__device__ void phase_ln(const float* Z, int M, const float* gam, const float* bet, float* Xout, float* Dout, bf16_t* H, const float* modl  , int shoff) {
    const int tid = tid_opaque(); const int lane = tid & 63, wid = tid >> 6;
    f32x4 gv[4], bv[4];
#pragma unroll
    for (int i = 0; i < 4; ++i) { gv[i] = *(const f32x4*)(gam + i * 256 + lane * 4); bv[i] = *(const f32x4*)(bet + i * 256 + lane * 4); }
    for (int row = blockIdx.x * NWAVES + wid; row < M; row += gridDim.x * NWAVES) {
        const float* zp = Z + (size_t)row * 1024 + lane * 4;
        f32x4 v[4];
#pragma unroll
        for (int i = 0; i < 4; ++i) v[i] = *(const f32x4*)(zp + i * 256);
        float s = 0.f;
#pragma unroll
        for (int i = 0; i < 4; ++i) s += (v[i][0] + v[i][1]) + (v[i][2] + v[i][3]);
#pragma unroll
        for (int o = 1; o < 64; o <<= 1) s += __shfl_xor(s, o);
        const float mean = s * (1.0f / 1024.0f);
        float q = 0.f;
#pragma unroll
        for (int i = 0; i < 4; ++i) { v[i] = v[i] - mean; q += (v[i][0] * v[i][0] + v[i][1] * v[i][1]) + (v[i][2] * v[i][2] + v[i][3] * v[i][3]); }
#pragma unroll
        for (int o = 1; o < 64; o <<= 1) q += __shfl_xor(q, o);
        const float rstd = rsqrtf(q * (1.0f / 1024.0f) + 1e-5f);
        const int mr = row < TL ? (row >> 11) : 32;
        const float* sh = modl + (size_t)mr * 6144 + shoff + lane * 4;
#pragma unroll
        for (int i = 0; i < 4; ++i) {
            const f32x4 y = v[i] * rstd * gv[i] + bv[i];
            if (Xout) *(f32x4*)(Xout + (size_t)row * 1024 + i * 256 + lane * 4) = y;
            if (Dout && row < TL) *(f32x4*)(Dout + (size_t)row * 1024 + i * 256 + lane * 4) = y;
            if (H) {
                const f32x4 shv = *(const f32x4*)(sh + i * 256), scv = *(const f32x4*)(sh + 1024 + i * 256);
                const f32x4 h = y * (scv + 1.0f) + shv;
                u32x2 w; w.x = cvt_pk_bf16(h[0], h[1]); w.y = cvt_pk_bf16(h[2], h[3]);
                *(u32x2*)(H + (size_t)row * 1024 + i * 256 + lane * 4) = w;
            }
        }
    }
}

__device__ void gmlp_unit(LAS unsigned char* lds, const bf16_t* __restrict__ P, bf16_t* __restrict__ Y, const float* lng, const float* lnb, const bf16_t* __restrict__ Aws, const float* abs_, int row0) {
    const int tid = tid_opaque(), wid = __builtin_amdgcn_readfirstlane(tid >> 6), lane = tid & 63, fr = lane & 15, fq = lane >> 4;
    LAS bf16_t* vT = (LAS bf16_t*)lds;
    {
        const int tok = tid >> 2, qd = tid & 3;
        const bf16_t* vp = P + (size_t)(row0 + tok) * 2048 + 256 + qd * 64;
        u32x4 raw[8];
#pragma unroll
        for (int i = 0; i < 8; ++i) raw[i] = *(const u32x4*)(vp + i * 8);
        float s = 0.f;
#pragma unroll
        for (int i = 0; i < 8; ++i)
#pragma unroll
            for (int e = 0; e < 4; ++e) s += bflo(raw[i][e]) + bfhi(raw[i][e]);
        s += __shfl_xor(s, 1); s += __shfl_xor(s, 2);
        const float mean = s * (1.0f / 256.0f);
        float q = 0.f;
#pragma unroll
        for (int i = 0; i < 8; ++i)
#pragma unroll
            for (int e = 0; e < 4; ++e) { const float a = bflo(raw[i][e]) - mean, b = bfhi(raw[i][e]) - mean; q += a * a + b * b; }
        q += __shfl_xor(q, 1); q += __shfl_xor(q, 2);
        const float rstd = rsqrtf(q * (1.0f / 256.0f) + 1e-5f);
#pragma unroll
        for (int i = 0; i < 8; ++i)
#pragma unroll
            for (int e = 0; e < 4; ++e) {
                const int ch = qd * 64 + i * 8 + e * 2;
                const float a = (bflo(raw[i][e]) - mean) * rstd * lng[ch] + lnb[ch];
                const float b = (bfhi(raw[i][e]) - mean) * rstd * lng[ch + 1] + lnb[ch + 1];
                const unsigned w = cvt_pk_bf16(a, b);
                vT[ch * 136 + tok] = (bf16_t)(w & 0xffffu); vT[(ch + 1) * 136 + tok] = (bf16_t)(w >> 16);
            }
    }
    __syncthreads();
    const int g = wid >> 1, ih = wid & 1;
    f32x4 acc[4][4];
#pragma unroll
    for (int a = 0; a < 4; ++a)
#pragma unroll
        for (int b = 0; b < 4; ++b) acc[a][b] = (f32x4){0.f, 0.f, 0.f, 0.f};
#pragma unroll
    for (int ks = 0; ks < 4; ++ks) {
        bf16x8 wf[4], vf[4];
#pragma unroll
        for (int it = 0; it < 4; ++it) wf[it] = *(const bf16x8*)(Aws + (size_t)((g * 128 + ih * 64 + it * 16 + fr) * 128 + ks * 32 + fq * 8));
#pragma unroll
        for (int ct = 0; ct < 4; ++ct) vf[ct] = *(const LAS bf16x8*)(vT + (g * 64 + ct * 16 + fr) * 136 + ks * 32 + fq * 8);
#pragma unroll
        for (int it = 0; it < 4; ++it)
#pragma unroll
            for (int ct = 0; ct < 4; ++ct) acc[it][ct] = __builtin_amdgcn_mfma_f32_16x16x32_bf16(vf[ct], wf[it], acc[it][ct], 0, 0, 0);
    }
#pragma unroll
    for (int it = 0; it < 4; ++it) {
        const int i = ih * 64 + it * 16 + fr; const float bias = abs_[g * 128 + i];
#pragma unroll
        for (int ct = 0; ct < 4; ++ct) {
            const int c0 = g * 64 + ct * 16 + fq * 4;
            const u32x2 uu = *(const u32x2*)(P + (size_t)(row0 + i) * 2048 + c0);
            const f32x4 a = acc[it][ct];
            u32x2 w; w.x = cvt_pk_bf16(bflo(uu.x) * (a[0] + bias), bfhi(uu.x) * (a[1] + bias)); w.y = cvt_pk_bf16(bflo(uu.y) * (a[2] + bias), bfhi(uu.y) * (a[3] + bias));
            *(u32x2*)(Y + (size_t)(row0 + i) * 1024 + c0) = w;
        }
    }
    __syncthreads();
}

struct AttnState { f32x4 o[4][4]; float m[4], l[4]; };

template <int MASK>
__device__ __forceinline__ void attn_tile(const bf16_t* __restrict__ kptr, const bf16_t* __restrict__ vtp, int vstride, const bf16x8 (&qf)[4][2], AttnState& st, int fr, int fq,
                                          int marg  , const float* __restrict__ rpbrow  ) {
    bf16x8 kf[2][2];
#pragma unroll
    for (int kt = 0; kt < 2; ++kt)
#pragma unroll
        for (int kk = 0; kk < 2; ++kk) kf[kt][kk] = *(const bf16x8*)(kptr + (size_t)(kt * 16 + fr) * 2048 + kk * 32 + fq * 8);
    bf16x8 vf[4];
#pragma unroll
    for (int dt = 0; dt < 4; ++dt) {
        const bf16_t* vp = vtp + (size_t)(dt * 16 + fr) * vstride + fq * 4;
        const bf16x4 lo = *(const bf16x4*)vp, hi = *(const bf16x4*)(vp + 16);
        vf[dt] = (bf16x8){lo[0], lo[1], lo[2], lo[3], hi[0], hi[1], hi[2], hi[3]};
    }
    f32x4 s[2][4];
#pragma unroll
    for (int kt = 0; kt < 2; ++kt)
#pragma unroll
        for (int qt = 0; qt < 4; ++qt) {
            f32x4 a = (f32x4){0.f, 0.f, 0.f, 0.f};
#pragma unroll
            for (int kk = 0; kk < 2; ++kk) a = __builtin_amdgcn_mfma_f32_16x16x32_bf16(kf[kt][kk], qf[qt][kk], a, 0, 0, 0);
            s[kt][qt] = a;
        }
    bf16x8 pf[4];
#pragma unroll
    for (int qt = 0; qt < 4; ++qt) {
        float mx = -INFINITY;
#pragma unroll
        for (int kt = 0; kt < 2; ++kt)
#pragma unroll
            for (int j = 0; j < 4; ++j) {
                float v = s[kt][qt][j];
                if (MASK == 1) {
                    const int cq = qt * 16 + fr, kc = marg + kt * 16 + fq * 4 + j;
                    int cs = cq - 8; cs = cs < 0 ? 0 : (cs > 48 ? 48 : cs);
                    const bool ok = (kc >= cs) && (kc < cs + 16);
                    const float bias = ok ? rpbrow[kc - cq + 15] : 0.f;
                    v = ok ? (v + bias) : -INFINITY;
                } else if (MASK == 2) {
                    const int d = marg + kt * 16 + fq * 4 + j - (qt * 16 + fr);
                    v = (d >= -128 && d <= 128) ? v : -INFINITY;
                }
                v *= LOG2E; s[kt][qt][j] = v; mx = fmaxf(mx, v);
            }
        mx = fmaxf(mx, __shfl_xor(mx, 16)); mx = fmaxf(mx, __shfl_xor(mx, 32));
        const float mnew = fmaxf(st.m[qt], mx);
        const float muse = (mnew == -INFINITY) ? 0.f : mnew;
        const float alpha = fexp2(st.m[qt] - muse);
        st.m[qt] = mnew;
        float ps = 0.f;
#pragma unroll
        for (int kt = 0; kt < 2; ++kt)
#pragma unroll
            for (int j = 0; j < 4; ++j) { const float pv = fexp2(s[kt][qt][j] - muse); s[kt][qt][j] = pv; ps += pv; }
        st.l[qt] = st.l[qt] * alpha + ps;
#pragma unroll
        for (int dt = 0; dt < 4; ++dt) st.o[dt][qt] = st.o[dt][qt] * alpha;
        u32x4 w; w.x = cvt_pk_bf16(s[0][qt][0], s[0][qt][1]); w.y = cvt_pk_bf16(s[0][qt][2], s[0][qt][3]); w.z = cvt_pk_bf16(s[1][qt][0], s[1][qt][1]); w.w = cvt_pk_bf16(s[1][qt][2], s[1][qt][3]);
        pf[qt] = __builtin_bit_cast(bf16x8, w);
    }
#pragma unroll
    for (int dt = 0; dt < 4; ++dt)
#pragma unroll
        for (int qt = 0; qt < 4; ++qt) st.o[dt][qt] = __builtin_amdgcn_mfma_f32_16x16x32_bf16(vf[dt], pf[qt], st.o[dt][qt], 0, 0, 0);
}

__device__ void attn_unit(const Params& p, int layer, int u, int lane) {
    const int fr = lane & 15, fq = lane >> 4;
    const bf16_t* P = (const bf16_t*)(p.ws + OFF_P);
    bf16_t* Y = (bf16_t*)(p.ws + OFF_Y);
    int mode, b, qcol, kcol, ycol, qrow0; const bf16_t* vt_l = nullptr; const bf16_t* vt_c; float sink = 0.f; bool has_sink = false;
    int r = 0, rs = 0, q0 = 0, h = 0;
    if (u < 4096) {
        mode = 0; r = u & 31; h = (u >> 5) & 3; b = u >> 7; rs = r - 4; rs = rs < 0 ? 0 : (rs > 24 ? 24 : rs);
        qrow0 = b * 2048 + r * 64; qcol = 512 + h * 64; kcol = 768 + h * 64; ycol = 256 + h * 64;
        vt_l = (const bf16_t*)(p.ws + OFF_VTNA_L) + (size_t)((b * 4 + h) * 64) * 2048; vt_c = (const bf16_t*)(p.ws + OFF_VTNA_C) + (size_t)((b * 4 + h) * 64) * 256;
    } else if (u < 12288) {
        const int v = u - 4096; mode = 1; const int qb = v & 1, g = (v >> 1) & 3, qpair = (v >> 3) & 15, kv = (v >> 7) & 1; b = v >> 8;
        const int qh = kv * 4 + g; q0 = (qpair * 2 + qb) * 64;
        qrow0 = b * 2048 + q0; qcol = 1280 + qh * 64; kcol = 1792 + kv * 64; ycol = 512 + qh * 64;
        vt_l = (const bf16_t*)(p.ws + OFF_VTSW_L) + (size_t)((b * 2 + kv) * 64) * 2048; vt_c = (const bf16_t*)(p.ws + OFF_VTSW_C) + (size_t)((b * 2 + kv) * 64) * 256;
        sink = p.sw_sink[layer * 8 + qh]; has_sink = true;
    } else {
        const int v = u - 12288; mode = 2; const int qblk = v & 3, hh = (v >> 2) % 12; b = v / 48;
        qrow0 = TL + b * 256 + qblk * 64;
        if (hh < 4) { qcol = 512 + hh * 64; kcol = 768 + hh * 64; ycol = 256 + hh * 64; vt_c = (const bf16_t*)(p.ws + OFF_VTNA_C) + (size_t)((b * 4 + hh) * 64) * 256; }
        else { const int qh = hh - 4, kv = qh >> 2; qcol = 1280 + qh * 64; kcol = 1792 + kv * 64; ycol = 512 + qh * 64; vt_c = (const bf16_t*)(p.ws + OFF_VTSW_C) + (size_t)((b * 2 + kv) * 64) * 256; sink = p.sw_sink[layer * 8 + qh]; has_sink = true; }
    }
    bf16x8 qf[4][2];
#pragma unroll
    for (int qt = 0; qt < 4; ++qt)
#pragma unroll
        for (int kk = 0; kk < 2; ++kk) qf[qt][kk] = *(const bf16x8*)(P + (size_t)(qrow0 + qt * 16 + fr) * 2048 + qcol + kk * 32 + fq * 8);
    AttnState st;
#pragma unroll
    for (int qt = 0; qt < 4; ++qt) { st.m[qt] = -INFINITY; st.l[qt] = 0.f;
#pragma unroll
        for (int dt = 0; dt < 4; ++dt) st.o[dt][qt] = (f32x4){0.f, 0.f, 0.f, 0.f}; }
    if (mode == 0) {
        const float* rpb = p.na_rpb + (size_t)((layer * 4 + h) * 15) * 31;
        for (int t = 0; t < 16; ++t) {
            const int kr = rs + (t >> 1), cbk = (t & 1) * 32, key0 = kr * 64 + cbk;
            attn_tile<1>(P + (size_t)(b * 2048 + key0) * 2048 + kcol, vt_l + key0, 2048, qf, st, fr, fq, cbk, rpb + (kr - r + 7) * 31);
        }
    } else if (mode == 1) {
        const int ks = q0 - 128 < 0 ? 0 : q0 - 128, ke = q0 + 192 > 2048 ? 2048 : q0 + 192;
        for (int key0 = ks; key0 < ke; key0 += 32)
            attn_tile<2>(P + (size_t)(b * 2048 + key0) * 2048 + kcol, vt_l + key0, 2048, qf, st, fr, fq, key0 - q0, nullptr);
    }
    for (int t = 0; t < 8; ++t)
        attn_tile<0>(P + (size_t)(TL + b * 256 + t * 32) * 2048 + kcol, vt_c + t * 32, 256, qf, st, fr, fq, 0, nullptr);
#pragma unroll
    for (int qt = 0; qt < 4; ++qt) {
        float lt = st.l[qt]; lt += __shfl_xor(lt, 16); lt += __shfl_xor(lt, 32);
        if (has_sink) lt += fexp2(sink * LOG2E - st.m[qt]);
        const float inv = 1.0f / lt;
        bf16_t* yp = Y + (size_t)(qrow0 + qt * 16 + fr) * 1024 + ycol + fq * 4;
#pragma unroll
        for (int dt = 0; dt < 4; ++dt) {
            const f32x4 o = st.o[dt][qt] * inv;
            u32x2 w; w.x = cvt_pk_bf16(o[0], o[1]); w.y = cvt_pk_bf16(o[2], o[3]);
            *(u32x2*)(yp + dt * 16) = w;
        }
    }
}

__device__ void phase_mixer(const Params& p, LAS unsigned char* lds, int layer) {
    const bf16_t* P = (const bf16_t*)(p.ws + OFF_P);
    bf16_t* Y = (bf16_t*)(p.ws + OFF_Y);
    const int nchunks = layer == 0 ? (TT / 128) : (TL / 128);
    for (int cu = blockIdx.x; cu < nchunks; cu += gridDim.x)
        gmlp_unit(lds, P, Y, p.a_ln_g + layer * 256, p.a_ln_b + layer * 256, (const bf16_t*)(p.ws + OFF_AWS) + (size_t)layer * 4 * 128 * 128, p.a_bs + layer * 512, cu * 128);
    const int tid = tid_opaque(); const int lane = tid & 63, wid = __builtin_amdgcn_readfirstlane(tid >> 6);
    const int nunits = layer == 0 ? 13824 : 12288;
    for (int u = blockIdx.x * NWAVES + wid; u < nunits; u += gridDim.x * NWAVES) attn_unit(p, layer, u, lane);
}

__device__ __forceinline__ void gsync(unsigned* bar) {
    asm volatile("s_waitcnt vmcnt(0) lgkmcnt(0)" ::: "memory");
    __syncthreads();
    if (threadIdx.x == 0) {
        __builtin_amdgcn_fence(__ATOMIC_RELEASE, "agent");
        asm volatile("s_waitcnt vmcnt(0)" ::: "memory");
        __hip_atomic_fetch_add(bar, 1u, __ATOMIC_RELAXED, __HIP_MEMORY_SCOPE_AGENT);
        while (__hip_atomic_load(bar, __ATOMIC_RELAXED, __HIP_MEMORY_SCOPE_AGENT) < gridDim.x) __builtin_amdgcn_s_sleep(2);
    }
    __syncthreads();
    __builtin_amdgcn_fence(__ATOMIC_ACQUIRE, "agent");
    asm volatile("s_waitcnt vmcnt(0) lgkmcnt(0)" ::: "memory");
}
__global__ void __launch_bounds__(NTHREADS) fwd_megakernel(Params p) {
    extern __shared__ __attribute__((aligned(16))) unsigned char lds_raw[];
    LAS unsigned char* lds = (LAS unsigned char*)lds_raw;
    cg::grid_group grid = cg::this_grid();
    if (!grid.is_valid()) return;
    bf16_t* H = (bf16_t*)p.out;
    float* XZ = (float*)(p.ws + OFF_XZ);
    const float* mod = (const float*)(p.ws + OFF_MOD);
    bf16_t* Pb = (bf16_t*)(p.ws + OFF_P); bf16_t* Yb = (bf16_t*)(p.ws + OFF_Y); bf16_t* Ub = (bf16_t*)(p.ws + OFF_U);

    phase_prologue(p, lds);
    gsync((unsigned*)(p.ws + OFF_BAR) + 0);
    phase_modulate0(p, H);
    gsync((unsigned*)(p.ws + OFF_BAR) + 1);
#pragma unroll 1
    for (int l = 0; l < 2; ++l) {
        const float* modl = mod + (size_t)l * 33 * 6144;
        const int Mres = (l == 1) ? TL : TT;
        {   EpiIn e; e.P = Pb; e.ws = p.ws;
            e.rcos = (const float*)(p.ws + OFF_ROPE); e.rsin = e.rcos + 1024;
            gemm_phase(lds, H, (const bf16_t*)(p.ws + OFF_WIN) + (size_t)l * 2048 * 1024, TT, 2048, 1024, e); }
        gsync((unsigned*)(p.ws + OFF_BAR) + 2 + l * 8);
        phase_mixer(p, lds, l);
        gsync((unsigned*)(p.ws + OFF_BAR) + 3 + l * 8);
        {   EpiRes e; e.res_lat = (l == 0) ? p.x : XZ; e.res_ctx = (l == 0) ? p.ctx : XZ + (size_t)TL * 1024; e.g = modl + 2048; e.out = XZ;
            gemm_phase(lds, Yb, (const bf16_t*)(p.ws + OFF_WOUT) + (size_t)l * 1024 * 1024, Mres, 1024, 1024, e); }
        gsync((unsigned*)(p.ws + OFF_BAR) + 4 + l * 8);
        phase_ln(XZ, Mres, p.ln1_g + l * 1024, p.ln1_b + l * 1024, XZ, nullptr, H, modl, 3072);
        gsync((unsigned*)(p.ws + OFF_BAR) + 5 + l * 8);
        {   EpiRelu2 e; e.U = Ub;
            gemm_phase(lds, H, (const bf16_t*)(p.ws + OFF_W1) + (size_t)l * 4096 * 1024, Mres, 4096, 1024, e); }
        gsync((unsigned*)(p.ws + OFF_BAR) + 6 + l * 8);
        {   EpiRes e; e.res_lat = XZ; e.res_ctx = XZ + (size_t)TL * 1024; e.g = modl + 5120; e.out = XZ;
            gemm_phase(lds, Ub, (const bf16_t*)(p.ws + OFF_W2) + (size_t)l * 1024 * 4096, Mres, 1024, 4096, e); }
        gsync((unsigned*)(p.ws + OFF_BAR) + 7 + l * 8);
        if (l == 0) { phase_ln(XZ, Mres, p.ln2_g, p.ln2_b, XZ, nullptr, H, mod + (size_t)33 * 6144, 0); gsync((unsigned*)(p.ws + OFF_BAR) + 8 + l * 8); }
        else phase_ln(XZ, Mres, p.ln2_g + 1024, p.ln2_b + 1024, nullptr, p.out, nullptr, modl, 0);
    }
}

extern "C" void kernel_launch(void* const* d_in, const int* in_sizes, int n_in, void* d_out, int out_size, void* d_ws, size_t ws_size, hipStream_t stream) {
    static int grid_blocks = 0;
    if (grid_blocks == 0) {
        if (n_in != 20 || out_size != TL * DM || ws_size < WS_END) { fprintf(stderr, "kernel_launch: unexpected shapes (n_in %d, out %d, ws %zu, need %zu)\n", n_in, out_size, ws_size, (size_t)WS_END); grid_blocks = -1; return; }
        int dev = 0, cus = 0, per_cu = 0;
        hipGetDevice(&dev);
        hipDeviceGetAttribute(&cus, hipDeviceAttributeMultiprocessorCount, dev);
        if (hipFuncSetAttribute((const void*)fwd_megakernel, hipFuncAttributeMaxDynamicSharedMemorySize, LDS_BYTES) != hipSuccess) { fprintf(stderr, "kernel_launch: hipFuncSetAttribute failed\n"); grid_blocks = -1; return; }
        if (hipOccupancyMaxActiveBlocksPerMultiprocessor(&per_cu, (const void*)fwd_megakernel, NTHREADS, LDS_BYTES) != hipSuccess || per_cu < 1) { fprintf(stderr, "kernel_launch: occupancy query gave %d\n", per_cu); per_cu = 1; }
        (void)hipGetLastError();
        grid_blocks = cus * per_cu;
    }
    if (grid_blocks < 0) return;
    Params p{};
    const float** f = (const float**)&p;
    for (int i = 0; i < 20; ++i) f[i] = (const float*)d_in[i];
    p.out = (float*)d_out; p.ws = (unsigned char*)d_ws;
    if (hipMemsetAsync((unsigned char*)d_ws + OFF_BAR, 0, 256, stream) != hipSuccess) { fprintf(stderr, "kernel_launch: memset failed\n"); return; }
    void* args[] = {&p};
    hipError_t e = hipLaunchCooperativeKernel((const void*)fwd_megakernel, dim3(grid_blocks), dim3(NTHREADS), args, LDS_BYTES, stream);
    if (e != hipSuccess) fprintf(stderr, "cooperative launch failed: %s (grid %d)\n", hipGetErrorString(e), grid_blocks);
}
```

```cpp
#include <hip/hip_runtime.h>
#include <hip/hip_cooperative_groups.h>
#include <cstdio>
#include <cstdint>
namespace cg = cooperative_groups;

typedef unsigned short bf16_t;
typedef short bf16x8 __attribute__((ext_vector_type(8)));
typedef short bf16x4 __attribute__((ext_vector_type(4)));
typedef float f32x4 __attribute__((ext_vector_type(4)));
typedef unsigned u32x2 __attribute__((ext_vector_type(2)));
typedef unsigned u32x4 __attribute__((ext_vector_type(4)));
#define LAS __attribute__((address_space(3)))

constexpr int DM = 1024, NB = 32, SEQ = 2048, CTXL = 256, TL = NB * SEQ, TC = NB * CTXL, TT = TL + TC, DFF = 4096, INW = 2048;
constexpr int NTHREADS = 512, NWAVES = 8;
constexpr int LDS_BYTES = 136 * 1024;
constexpr float ALPHA = 1.41421356237f;
constexpr float LOG2E = 1.4426950408889634f;

constexpr size_t OFF_WIN = 0;
constexpr size_t OFF_WOUT = OFF_WIN + 2ull * 2048 * 1024 * 2;
constexpr size_t OFF_W1 = OFF_WOUT + 2ull * 1024 * 1024 * 2;
constexpr size_t OFF_W2 = OFF_W1 + 2ull * 4096 * 1024 * 2;
constexpr size_t OFF_AWS = OFF_W2 + 2ull * 4096 * 1024 * 2;
constexpr size_t OFF_MOD = OFF_AWS + 2ull * 4 * 128 * 128 * 2;
constexpr size_t OFF_ROPE = OFF_MOD + 2ull * 33 * 6144 * 4;
constexpr size_t OFF_BAR = OFF_ROPE + 8192;
constexpr size_t OFF_XZ = OFF_BAR + 256;
constexpr size_t OFF_U = OFF_XZ + (size_t)TT * 1024 * 4;
constexpr size_t WS_END = OFF_U + (size_t)TT * 4096 * 2;
constexpr size_t OFF_P = OFF_U;
constexpr size_t OFF_Y = OFF_P + (size_t)TT * 2048 * 2;
constexpr size_t OFF_VTNA_L = OFF_Y + (size_t)TT * 1024 * 2;
constexpr size_t OFF_VTNA_C = OFF_VTNA_L + (size_t)NB * 4 * 64 * 2048 * 2;
constexpr size_t OFF_VTSW_L = OFF_VTNA_C + (size_t)NB * 4 * 64 * 256 * 2;
constexpr size_t OFF_VTSW_C = OFF_VTSW_L + (size_t)NB * 2 * 64 * 2048 * 2;
static_assert(OFF_VTSW_C + (size_t)NB * 2 * 64 * 256 * 2 <= WS_END, "overlay");

struct Params {
    const float *x, *c, *ctx, *c_ctx, *w_mod, *b_mod, *w_in, *a_ln_g, *a_ln_b, *a_ws, *a_bs, *na_rpb, *sw_sink, *w_out, *ln1_g, *ln1_b, *w1, *w2, *ln2_g, *ln2_b;
    float* out;
    unsigned char* ws;
};

typedef float f32x2 __attribute__((ext_vector_type(2)));
typedef __bf16 bf16v2 __attribute__((ext_vector_type(2)));
__device__ __forceinline__ unsigned cvt_pk_bf16(float lo, float hi) { f32x2 v = {lo, hi}; bf16v2 r = __builtin_convertvector(v, bf16v2); return __builtin_bit_cast(unsigned, r); }
__device__ __forceinline__ float bf2f(unsigned short v) { return __uint_as_float(((unsigned)v) << 16); }
__device__ __forceinline__ float bflo(unsigned v) { return __uint_as_float(v << 16); }
__device__ __forceinline__ float bfhi(unsigned v) { return __uint_as_float(v & 0xffff0000u); }
__device__ __forceinline__ float fexp2(float v) { return __builtin_amdgcn_exp2f(v); }
__device__ __forceinline__ int tid_opaque() { int t = threadIdx.x; asm volatile("" : "+v"(t)); return t; }

namespace pg8 {
#define PG8_LAS __attribute__((address_space(3)))
typedef unsigned short bf16_t;
typedef short bf16x8 __attribute__((ext_vector_type(8)));
typedef float f32x4 __attribute__((ext_vector_type(4)));
typedef unsigned u32x4 __attribute__((ext_vector_type(4)));
constexpr int BM = 256, BK = 64, HALF = 128, HTB = HALF * BK * 2  , STAGE_BYTES = 8 * HTB, NXCD = 8, WGM = 8;

__host__ __device__ __forceinline__ int lds_byte(int r, int c) { const int st = (r >> 4) * 2 + (c >> 5), rr = r & 15, cc = c & 31, ob = rr * 64 + cc * 2; return st * 1024 + (ob ^ (((ob >> 9) & 1) << 5)); }
__host__ __device__ __forceinline__ void stage_rc(int b, int& R, int& C) { const int st = b / 1024, sb = b % 1024, swz = sb ^ (((sb >> 9) & 1) << 5); R = (st >> 1) * 16 + swz / 64; C = (st & 1) * 32 + (swz % 64) / 2; }
__host__ __device__ __forceinline__ int perm32(int rho) { const int n = rho >> 4, i = rho & 15; return 8 * (i >> 2) + 4 * n + (i & 3); }

struct Unit { int pm, pn; };
struct Gemm { const bf16_t* A; const bf16_t* Bt; int M, N, K; };

struct StaticOrder {
    int nM, nN, nwg, G, c;
    __host__ __device__ void init(int M, int N, int G_, int c_) { nM = M / BM; nN = N / BM; nwg = nM * nN; G = G_; c = c_; }
    __host__ __device__ bool next(int i, Unit& u) const {
        const long L = (long)i * G + c; if (L >= nwg) return false;
        int wgid = (int)L; { const int q = nwg / NXCD, r = nwg % NXCD, xcd = wgid % NXCD, off = wgid / NXCD; wgid = (xcd < r ? xcd * (q + 1) : r * (q + 1) + (xcd - r) * q) + off; }
        const int nig = WGM * nN, gid = wgid / nig, fm = gid * WGM, gsz = (nM - fm) < WGM ? (nM - fm) : WGM;
        u.pm = fm + ((wgid % nig) % gsz); u.pn = (wgid % nig) / gsz; return true;
    }
    __device__ __forceinline__ void a_ready(const Unit&) const {}
    __device__ __forceinline__ void done(const Unit&) const {}
};
template <class Epi, class Sched, bool ALIGN_EPI = false, bool SP2 = false>
__device__ __forceinline__ void gemm_phase(PG8_LAS unsigned char* lds, const Gemm g, const Sched& S, const Epi& E) {
    const int tid = tid_opaque(), wid = __builtin_amdgcn_readfirstlane(tid >> 6), lane = tid & 63, wr = wid >> 2, wc = wid & 3, fr = lane & 15, fq = lane >> 4;
    const int K = g.K, nt = K / BK;
    unsigned voffA[2], voffB[2];
#pragma unroll
    for (int i = 0; i < 2; ++i) { int R, C; stage_rc(tid * 16 + i * 8192, R, C); const int Rb = Epi::PERM ? ((R & ~31) + perm32(R & 31)) : R;
        voffA[i] = (unsigned)(R * K + C) * 2u; voffB[i] = (unsigned)(Rb * K + C) * 2u; }
    const size_t kstep = (size_t)(BK * 2);
    const size_t hstep = (size_t)HALF * K * 2;
    const size_t tstep = 2 * hstep;
    const unsigned ldsw = (unsigned)wid * 1024u;
    const int aoff = lds_byte(wr * 64 + fr, fq * 8), boff = lds_byte(wc * 32 + fr, fq * 8);
#define PG8_SA(b, h) (((b) * 2 + (h)) * HTB)
#define PG8_SB(b, h) ((4 + (b) * 2 + (h)) * HTB)
#define PG8_STAGE(bufoff, gbase, voff) do { _Pragma("unroll") for (int _i = 0; _i < 2; ++_i) \
        __builtin_amdgcn_global_load_lds((const unsigned*)((const char*)(gbase) + (voff)[_i]), (PG8_LAS unsigned*)(lds + (bufoff) + ldsw + _i * 8192), 16, 0, 0); } while (0)
#define PG8_LDA(dst, b, h) do { _Pragma("unroll") for (int m = 0; m < 4; ++m) _Pragma("unroll") for (int k = 0; k < 2; ++k) dst[m][k] = *(const PG8_LAS bf16x8*)(lds + PG8_SA(b, h) + aoff + m * 2048 + k * 1024); } while (0)
#define PG8_LDB(dst, b, h) do { _Pragma("unroll") for (int n = 0; n < 2; ++n) _Pragma("unroll") for (int k = 0; k < 2; ++k) dst[n][k] = *(const PG8_LAS bf16x8*)(lds + PG8_SB(b, h) + boff + n * 2048 + k * 1024); } while (0)
#define PG8_MMA(ai, bj, At, Bt) do { __builtin_amdgcn_s_setprio(1); _Pragma("unroll") for (int m = 0; m < 4; ++m) _Pragma("unroll") for (int n = 0; n < 2; ++n) _Pragma("unroll") for (int k = 0; k < 2; ++k) \
        acc[ai][bj][m][n] = __builtin_amdgcn_mfma_f32_16x16x32_bf16(Bt[n][k], At[m][k], acc[ai][bj][m][n], 0, 0, 0); __builtin_amdgcn_s_setprio(0); } while (0)
#define PG8_WAIT_V(n) asm volatile("s_waitcnt vmcnt(" #n ")" ::: "memory")
#define PG8_WAIT_L(n) asm volatile("s_waitcnt lgkmcnt(" #n ")" ::: "memory")
#define PG8_BAR __builtin_amdgcn_s_barrier()
#define PG8_SCHED __builtin_amdgcn_sched_barrier(0)
    Unit cur, nxt; int ui = 0;
    if (!S.next(0, cur)) return;
    f32x4 acc[2][2][4][2];
#pragma unroll
    for (int a = 0; a < 2; ++a)
#pragma unroll
        for (int b = 0; b < 2; ++b)
#pragma unroll
            for (int m = 0; m < 4; ++m)
#pragma unroll
                for (int n = 0; n < 2; ++n) acc[a][b][m][n] = (f32x4){0.f, 0.f, 0.f, 0.f};
    bf16x8 At[4][2], B0[2][2], B1[2][2];
    const char* cA = (const char*)g.A + (size_t)cur.pm * tstep; const char* cB = (const char*)g.Bt + (size_t)cur.pn * tstep;
    S.a_ready(cur);
    if constexpr (SP2) {
        PG8_STAGE(PG8_SB(0, 0), cB, voffB); PG8_STAGE(PG8_SB(0, 1), cB + hstep, voffB); PG8_STAGE(PG8_SA(0, 0), cA, voffA); PG8_STAGE(PG8_SA(0, 1), cA + hstep, voffA);
        if (wr == 1) PG8_BAR;
        PG8_WAIT_V(2); PG8_BAR;
        PG8_STAGE(PG8_SB(1, 0), cB + kstep, voffB); PG8_STAGE(PG8_SA(1, 0), cA + kstep, voffA); PG8_STAGE(PG8_SB(1, 1), cB + hstep + kstep, voffB);
        PG8_WAIT_V(6); PG8_BAR;
    } else {
        PG8_STAGE(PG8_SB(0, 0), cB, voffB); PG8_STAGE(PG8_SA(0, 0), cA, voffA); PG8_STAGE(PG8_SB(0, 1), cB + hstep, voffB); PG8_STAGE(PG8_SA(0, 1), cA + hstep, voffA);
        if (wr == 1) PG8_BAR;
        PG8_WAIT_V(4); PG8_BAR;
        PG8_STAGE(PG8_SB(1, 0), cB + kstep, voffB); PG8_STAGE(PG8_SA(1, 0), cA + kstep, voffA); PG8_STAGE(PG8_SB(1, 1), cB + hstep + kstep, voffB);
        PG8_WAIT_V(6); PG8_BAR;
    }
    for (;;) {
        const bool has_next = S.next(ui + 1, nxt);
        const char* nA = has_next ? (const char*)g.A + (size_t)nxt.pm * tstep : cA; const char* nB = has_next ? (const char*)g.Bt + (size_t)nxt.pn * tstep : cB;
        for (int t = 0; t < nt; t += 2) {
            const bool last = (t == nt - 2);
            const char* a1 = cA + (size_t)(t + 1) * kstep;
            const char* a2 = last ? nA : cA + (size_t)(t + 2) * kstep; const char* b2 = last ? nB : cB + (size_t)(t + 2) * kstep;
            const char* a3 = a2 + kstep; const char* b3 = b2 + kstep;
            if (last && has_next) S.a_ready(nxt);
            if constexpr (SP2) {
            PG8_LDB(B0, 0, 0); PG8_LDB(B1, 0, 1); PG8_SCHED; PG8_LDA(At, 0, 0); PG8_STAGE(PG8_SA(1, 1), a1 + hstep, voffA);
            PG8_WAIT_V(8); PG8_WAIT_L(0); PG8_BAR; PG8_MMA(0, 0, At, B0); PG8_MMA(0, 1, At, B1); PG8_BAR; PG8_SCHED;
            PG8_LDA(At, 0, 1); PG8_STAGE(PG8_SB(0, 0), b2, voffB); PG8_STAGE(PG8_SB(0, 1), b2 + hstep, voffB); PG8_STAGE(PG8_SA(0, 0), a2, voffA);
            PG8_WAIT_V(8); PG8_WAIT_L(0); PG8_BAR; PG8_MMA(1, 0, At, B0); PG8_MMA(1, 1, At, B1); PG8_BAR; PG8_SCHED;
            PG8_LDB(B0, 1, 0); PG8_LDB(B1, 1, 1); PG8_SCHED; PG8_LDA(At, 1, 0); PG8_STAGE(PG8_SA(0, 1), a2 + hstep, voffA);
            PG8_WAIT_V(8); PG8_WAIT_L(0); PG8_BAR; PG8_MMA(0, 0, At, B0); PG8_MMA(0, 1, At, B1); PG8_BAR; PG8_SCHED;
            PG8_LDA(At, 1, 1); PG8_STAGE(PG8_SB(1, 0), b3, voffB); PG8_STAGE(PG8_SB(1, 1), b3 + hstep, voffB); PG8_STAGE(PG8_SA(1, 0), a3, voffA);
            PG8_WAIT_V(8); PG8_WAIT_L(0); PG8_BAR; PG8_MMA(1, 0, At, B0); PG8_MMA(1, 1, At, B1); PG8_BAR; PG8_SCHED;
            } else {
            PG8_LDB(B0, 0, 0); PG8_SCHED; PG8_LDA(At, 0, 0); PG8_STAGE(PG8_SA(1, 1), a1 + hstep, voffA);
            PG8_WAIT_L(8); PG8_BAR; PG8_WAIT_L(0); PG8_MMA(0, 0, At, B0); PG8_BAR; PG8_SCHED;
            PG8_LDB(B1, 0, 1); PG8_STAGE(PG8_SB(0, 0), b2, voffB);
            PG8_BAR; PG8_WAIT_L(0); PG8_MMA(0, 1, At, B1); PG8_BAR;
            PG8_LDA(At, 0, 1); PG8_STAGE(PG8_SA(0, 0), a2, voffA);
            PG8_BAR; PG8_WAIT_L(0); PG8_MMA(1, 0, At, B0); PG8_BAR; PG8_SCHED;
            PG8_STAGE(PG8_SB(0, 1), b2 + hstep, voffB);
            PG8_WAIT_V(6); PG8_BAR; PG8_MMA(1, 1, At, B1); PG8_BAR;
            PG8_LDB(B0, 1, 0); PG8_SCHED; PG8_LDA(At, 1, 0); PG8_STAGE(PG8_SA(0, 1), a2 + hstep, voffA);
            PG8_WAIT_L(8); PG8_BAR; PG8_WAIT_L(0); PG8_MMA(0, 0, At, B0); PG8_BAR; PG8_SCHED;
            PG8_LDB(B1, 1, 1); PG8_STAGE(PG8_SB(1, 0), b3, voffB);
            PG8_BAR; PG8_WAIT_L(0); PG8_MMA(0, 1, At, B1); PG8_BAR;
            PG8_LDA(At, 1, 1); PG8_STAGE(PG8_SA(1, 0), a3, voffA);
            PG8_BAR; PG8_WAIT_L(0); PG8_MMA(1, 0, At, B0); PG8_BAR; PG8_SCHED;
            PG8_STAGE(PG8_SB(1, 1), b3 + hstep, voffB);
            PG8_WAIT_V(6); PG8_BAR; PG8_MMA(1, 1, At, B1); PG8_BAR;
            }
        }
        if constexpr (ALIGN_EPI) { if (wr == 0) PG8_BAR; }
        if constexpr (!Epi::AFTER_DRAIN) { E(acc, cur, wr, wc, fr, fq); S.done(cur); }
        if (!has_next) break;
#pragma unroll
        for (int a = 0; a < 2; ++a)
#pragma unroll
            for (int b = 0; b < 2; ++b)
#pragma unroll
                for (int m = 0; m < 4; ++m)
#pragma unroll
                    for (int n = 0; n < 2; ++n) acc[a][b][m][n] = (f32x4){0.f, 0.f, 0.f, 0.f};
        cur = nxt; cA = nA; cB = nB; ++ui;
        if constexpr (ALIGN_EPI) { if (wr == 1) PG8_BAR; }
    }
    PG8_WAIT_V(0);
    if constexpr (!ALIGN_EPI) { if (wr == 0) PG8_BAR; }
    PG8_BAR;
    if constexpr (Epi::AFTER_DRAIN) { E.fused(acc, cur, wr, wc, fr, fq, lds, wid, lane); S.done(cur); }
#undef PG8_SA
#undef PG8_SB
#undef PG8_STAGE
#undef PG8_LDA
#undef PG8_LDB
#undef PG8_MMA
#undef PG8_WAIT_V
#undef PG8_WAIT_L
#undef PG8_BAR
#undef PG8_SCHED
}
}

using pg8::Unit;
__device__ __forceinline__ float gelu_tanh(float v) {
    const float u = 0.7978845608028654f * (v + 0.044715f * v * v * v);
    return v / (1.0f + __expf(-2.0f * u));
}

struct EpiIn {
    static constexpr bool PERM = false, AFTER_DRAIN = false;
    bf16_t* P; const float* rcos; const float* rsin;
    __device__ __forceinline__ void operator()(const f32x4 (&acc)[2][2][4][2], const Unit& u, int wr, int wc, int fr, int fq) const {
#pragma unroll
        for (int bj = 0; bj < 2; ++bj) {
            const int cg = u.pn * 256 + bj * 128 + wc * 32;
            const bool lat = u.pm * 256 < TL;
            const int emode = cg < 512 ? 1 : ((cg >= 1280 && cg < 1920 && lat) ? 2 : 0);
            const float sc = ((cg >= 512 && cg < 768) || (cg >= 1280 && cg < 1792)) ? 0.125f : 1.0f;
            const bool colrot = (cg & 32) != 0;
#pragma unroll
            for (int ai = 0; ai < 2; ++ai)
#pragma unroll
                for (int m = 0; m < 4; ++m) {
                    const int row = u.pm * 256 + ai * 128 + wr * 64 + m * 16 + fr;
                    f32x4 v0 = acc[ai][bj][m][0], v1 = acc[ai][bj][m][1];
                    if (emode == 1) {
#pragma unroll
                        for (int j = 0; j < 4; ++j) { v0[j] = gelu_tanh(v0[j]); v1[j] = gelu_tanh(v1[j]); }
                    } else if (emode == 2) {
                        const int s = row & 2047; const int pos = colrot ? (s & 63) : (s >> 6);
                        const f32x4 c = *(const f32x4*)(rcos + pos * 16 + 4 * fq), sn = *(const f32x4*)(rsin + pos * 16 + 4 * fq);
                        const f32x4 a0 = v0, a1 = v1;
                        v0 = a0 * c - a1 * sn; v1 = a0 * sn + a1 * c;
                    }
                    bf16_t* rowp = P + (size_t)row * 2048 + cg + 4 * fq;
                    u32x2 w;
                    w.x = cvt_pk_bf16(v0[0] * sc, v0[1] * sc); w.y = cvt_pk_bf16(v0[2] * sc, v0[3] * sc); *(u32x2*)(rowp) = w;
                    w.x = cvt_pk_bf16(v1[0] * sc, v1[1] * sc); w.y = cvt_pk_bf16(v1[2] * sc, v1[3] * sc); *(u32x2*)(rowp + 16) = w;
                }
        }
    }
};

struct EpiRes {
    static constexpr bool PERM = false, AFTER_DRAIN = false;
    const float* res_lat; const float* res_ctx; const float* g; float* out;
    __device__ __forceinline__ void operator()(const f32x4 (&acc)[2][2][4][2], const Unit& u, int wr, int wc, int fr, int fq) const {
        const int rowt = u.pm * 256;
        const int mr = rowt < TL ? (rowt >> 11) : 32;
        const int c0 = u.pn * 256 + wc * 32 + 4 * fq;
        const float* gp = g + (size_t)mr * 6144 + c0;
        f32x4 gg[2][2];
#pragma unroll
        for (int bj = 0; bj < 2; ++bj)
#pragma unroll
            for (int n = 0; n < 2; ++n) gg[bj][n] = *(const f32x4*)(gp + bj * 128 + n * 16);
        const float* rbase = rowt < TL ? res_lat + (size_t)rowt * 1024 : res_ctx + (size_t)(rowt - TL) * 1024;
#pragma unroll
        for (int ai = 0; ai < 2; ++ai)
#pragma unroll
            for (int m = 0; m < 4; ++m) {
                const int rl = ai * 128 + wr * 64 + m * 16 + fr;
                const float* rp = rbase + (size_t)rl * 1024 + c0;
                float* op = out + (size_t)(rowt + rl) * 1024 + c0;
#pragma unroll
                for (int bj = 0; bj < 2; ++bj)
#pragma unroll
                    for (int n = 0; n < 2; ++n) { const f32x4 r = *(const f32x4*)(rp + bj * 128 + n * 16); *(f32x4*)(op + bj * 128 + n * 16) = r * ALPHA + gg[bj][n] * acc[ai][bj][m][n]; }
            }
    }
};

struct EpiRelu2 {
    static constexpr bool PERM = true, AFTER_DRAIN = false;
    bf16_t* U;
    __device__ __forceinline__ void operator()(const f32x4 (&acc)[2][2][4][2], const Unit& u, int wr, int wc, int fr, int fq) const {
        const int c0 = u.pn * 256 + wc * 32 + 8 * fq;
#pragma unroll
        for (int ai = 0; ai < 2; ++ai)
#pragma unroll
            for (int m = 0; m < 4; ++m) {
                bf16_t* rowp = U + (size_t)(u.pm * 256 + ai * 128 + wr * 64 + m * 16 + fr) * 4096 + c0;
#pragma unroll
                for (int bj = 0; bj < 2; ++bj) {
                    f32x4 v0 = acc[ai][bj][m][0], v1 = acc[ai][bj][m][1];
#pragma unroll
                    for (int j = 0; j < 4; ++j) { const float t0 = fmaxf(v0[j], 0.f), t1 = fmaxf(v1[j], 0.f); v0[j] = t0 * t0; v1[j] = t1 * t1; }
                    u32x4 w; w.x = cvt_pk_bf16(v0[0], v0[1]); w.y = cvt_pk_bf16(v0[2], v0[3]); w.z = cvt_pk_bf16(v1[0], v1[1]); w.w = cvt_pk_bf16(v1[2], v1[3]);
                    *(u32x4*)(rowp + bj * 128) = w;
                }
            }
    }
};

template <class Epi>
__device__ __forceinline__ void gemm_phase(LAS unsigned char* lds, const bf16_t* A, const bf16_t* Bt, int M, int N, int K, const Epi& epi) {
    pg8::Gemm g; g.A = A; g.Bt = Bt; g.M = M; g.N = N; g.K = K;
    pg8::StaticOrder so; so.init(M, N, (int)gridDim.x, (int)blockIdx.x);
    pg8::gemm_phase<Epi, pg8::StaticOrder, true, true>(lds, g, so, epi);
}

__device__ void phase_vtrans(const Params& p, LAS unsigned char* lds) {
    const int tid = tid_opaque(); const int lane = tid & 63, wid = __builtin_amdgcn_readfirstlane(tid >> 6);
    LAS bf16_t* sl = (LAS bf16_t*)(lds + wid * 9216);
    const bf16_t* P = (const bf16_t*)(p.ws + OFF_P);
    for (int u = blockIdx.x * NWAVES + wid; u < 6144 + 768; u += gridDim.x * NWAVES) {
        int b, hd, tile, row0, stride;
        if (u < 6144) { tile = u & 31; hd = (u >> 5) % 6; b = u / 192; row0 = b * 2048 + tile * 64; stride = 2048; }
        else { const int v = u - 6144; tile = v & 3; hd = (v >> 2) % 6; b = v / 24; row0 = TL + b * 256 + tile * 64; stride = 256; }
        const int vcol = hd < 4 ? 1024 + hd * 64 : 1920 + (hd - 4) * 64;
        const size_t off = u < 6144 ? (hd < 4 ? OFF_VTNA_L : OFF_VTSW_L) : (hd < 4 ? OFF_VTNA_C : OFF_VTSW_C);
        const int hh = hd < 4 ? (b * 4 + hd) : (b * 2 + hd - 4);
        bf16_t* dst = (bf16_t*)(p.ws + off) + (size_t)(hh * 64) * stride + tile * 64;
        const bf16_t* src = P + (size_t)(row0 + lane) * 2048 + vcol;
#pragma unroll
        for (int i = 0; i < 8; ++i) *(LAS u32x4*)(sl + lane * 72 + i * 8) = *(const u32x4*)(src + i * 8);
        asm volatile("s_waitcnt vmcnt(0) lgkmcnt(0)" ::: "memory");
#pragma unroll
        for (int i = 0; i < 8; ++i) {
            u32x4 w;
#pragma unroll
            for (int e = 0; e < 4; ++e) { const unsigned lo = sl[(i * 8 + 2 * e) * 72 + lane], hi = sl[(i * 8 + 2 * e + 1) * 72 + lane]; w[e] = lo | (hi << 16); }
            *(u32x4*)(dst + (size_t)lane * stride + i * 8) = w;
        }
        asm volatile("s_waitcnt lgkmcnt(0)" ::: "memory");
    }
}

__device__ __forceinline__ void transpose_tile(const float* __restrict__ src, bf16_t* __restrict__ dst, int K, int N, int kb, int nb, LAS float* lt) {
    const int tid = tid_opaque();
    { const int n = tid & 63, k0 = tid >> 6;
#pragma unroll
      for (int i = 0; i < 8; ++i) { const int k = k0 + 8 * i; lt[k * 65 + n] = src[(size_t)(kb + k) * N + nb + n]; } }
    __syncthreads();
    { const int kp = tid & 31, n0 = tid >> 5;
#pragma unroll
      for (int i = 0; i < 4; ++i) { const int n = n0 + 16 * i; const unsigned w = cvt_pk_bf16(lt[(2 * kp) * 65 + n], lt[(2 * kp + 1) * 65 + n]); *(unsigned*)(dst + (size_t)(nb + n) * K + kb + 2 * kp) = w; } }
    __syncthreads();
}

__device__ void phase_prologue(const Params& p, LAS unsigned char* lds) {
    const int tid = tid_opaque();
    LAS float* lf = (LAS float*)lds;
    for (int u = blockIdx.x; u < 192; u += gridDim.x) {
        const int l = u / 96, nb = (u % 96) * 64;
        for (int idx = tid; idx < 33 * 1024; idx += NTHREADS) { const int r = idx >> 10, k = idx & 1023; const float v = r < 32 ? p.c[r * 1024 + k] : p.c_ctx[k]; lf[idx] = v / (1.0f + __expf(-v)); }
        __syncthreads();
        const int n = tid & 63, s = __builtin_amdgcn_readfirstlane(tid >> 6);
        float acc[33];
#pragma unroll
        for (int r = 0; r < 33; ++r) acc[r] = 0.f;
        const float* wp = p.w_mod + ((size_t)l * 1024 + s * 128) * 6144 + nb + n;
        for (int k = 0; k < 128; ++k) {
            const float w = wp[(size_t)k * 6144];
            const LAS float* sp = lf + s * 128 + k;
#pragma unroll
            for (int r = 0; r < 33; ++r) acc[r] += sp[r * 1024] * w;
        }
        __syncthreads();
#pragma unroll
        for (int r = 0; r < 33; ++r) lf[(s * 33 + r) * 64 + n] = acc[r];
        __syncthreads();
        for (int idx = tid; idx < 33 * 64; idx += NTHREADS) {
            const int r = idx >> 6, nn = idx & 63; float sum = p.b_mod[l * 6144 + nb + nn];
#pragma unroll
            for (int ss = 0; ss < 8; ++ss) sum += lf[(ss * 33 + r) * 64 + nn];
            ((float*)(p.ws + OFF_MOD))[((size_t)l * 33 + r) * 6144 + nb + nn] = sum;
        }
        __syncthreads();
    }
    for (int u = blockIdx.x; u < 2 * 2816; u += gridDim.x) {
        const int l = u / 2816; int r = u % 2816;
        if (r < 512) { const int kb = (r >> 5) * 64, nb = (r & 31) * 64; transpose_tile(p.w_in + (size_t)l * 1024 * 2048, (bf16_t*)(p.ws + OFF_WIN) + (size_t)l * 2048 * 1024, 1024, 2048, kb, nb, lf); }
        else if (r < 768) { r -= 512; const int kb = (r >> 4) * 64, nb = (r & 15) * 64; transpose_tile(p.w_out + (size_t)l * 1024 * 1024, (bf16_t*)(p.ws + OFF_WOUT) + (size_t)l * 1024 * 1024, 1024, 1024, kb, nb, lf); }
        else if (r < 1792) { r -= 768; const int kb = (r >> 6) * 64, nb = (r & 63) * 64; transpose_tile(p.w1 + (size_t)l * 1024 * 4096, (bf16_t*)(p.ws + OFF_W1) + (size_t)l * 4096 * 1024, 1024, 4096, kb, nb, lf); }
        else { r -= 1792; const int kb = (r >> 4) * 64, nb = (r & 15) * 64; transpose_tile(p.w2 + (size_t)l * 4096 * 1024, (bf16_t*)(p.ws + OFF_W2) + (size_t)l * 1024 * 4096, 4096, 1024, kb, nb, lf); }
    }
    const int gt = blockIdx.x * NTHREADS + tid, gn = gridDim.x * NTHREADS;
    for (int i = gt; i < 2 * 4 * 128 * 128 / 2; i += gn) { ((unsigned*)(p.ws + OFF_AWS))[i] = cvt_pk_bf16(p.a_ws[2 * i], p.a_ws[2 * i + 1]); }
    for (int i = gt; i < 1024; i += gn) {
        const int pos = i >> 4, f = i & 15; const float inv = powf(10000.0f, -(float)f / 16.0f); const float ang = (float)pos * inv;
        ((float*)(p.ws + OFF_ROPE))[i] = cosf(ang); ((float*)(p.ws + OFF_ROPE))[1024 + i] = sinf(ang);
    }
}

__device__ void phase_modulate0(const Params& p, bf16_t* H) {
    const float* mod = (const float*)(p.ws + OFF_MOD);
    const size_t total = (size_t)TT * 128, gn = (size_t)gridDim.x * NTHREADS;
    for (size_t i = (size_t)blockIdx.x * NTHREADS + tid_opaque(); i < total; i += gn) {
        const int row = (int)(i >> 7), c8 = (int)(i & 127) * 8;
        const float* src = (row < TL ? p.x + (size_t)row * 1024 : p.ctx + (size_t)(row - TL) * 1024) + c8;
        const int mr = row < TL ? (row >> 11) : 32;
        const float* sh = mod + (size_t)mr * 6144 + c8; const float* sc = sh + 1024;
        const f32x4 a = *(const f32x4*)src, b = *(const f32x4*)(src + 4);
        const f32x4 sa = *(const f32x4*)sh, sb = *(const f32x4*)(sh + 4), ca = *(const f32x4*)sc, cb = *(const f32x4*)(sc + 4);
        const f32x4 ya = a * (ca + 1.0f) + sa, yb = b * (cb + 1.0f) + sb;
        u32x4 w; w.x = cvt_pk_bf16(ya[0], ya[1]); w.y = cvt_pk_bf16(ya[2], ya[3]); w.z = cvt_pk_bf16(yb[0], yb[1]); w.w = cvt_pk_bf16(yb[2], yb[3]);
        *(u32x4*)(H + (size_t)row * 1024 + c8) = w;
    }
}

__device__ void phase_ln(const float* Z, int M, const float* gam, const float* bet, float* Xout, float* Dout, bf16_t* H, const float* modl  , int shoff) {
    const int tid = tid_opaque(); const int lane = tid & 63, wid = tid >> 6;
    f32x4 gv[4], bv[4];
#pragma unroll
    for (int i = 0; i < 4; ++i) { gv[i] = *(const f32x4*)(gam + i * 256 + lane * 4); bv[i] = *(const f32x4*)(bet + i * 256 + lane * 4); }
    for (int row = blockIdx.x * NWAVES + wid; row < M; row += gridDim.x * NWAVES) {
        const float* zp = Z + (size_t)row * 1024 + lane * 4;
        f32x4 v[4];
#pragma unroll
        for (int i = 0; i < 4; ++i) v[i] = *(const f32x4*)(zp + i * 256);
        float s = 0.f;
#pragma unroll
        for (int i = 0; i < 4; ++i) s += (v[i][0] + v[i][1]) + (v[i][2] + v[i][3]);
#pragma unroll
        for (int o = 1; o < 64; o <<= 1) s += __shfl_xor(s, o);
        const float mean = s * (1.0f / 1024.0f);
        float q = 0.f;
#pragma unroll
        for (int i = 0; i < 4; ++i) { v[i] = v[i] - mean; q += (v[i][0] * v[i][0] + v[i][1] * v[i][1]) + (v[i][2] * v[i][2] + v[i][3] * v[i][3]); }
#pragma unroll
        for (int o = 1; o < 64; o <<= 1) q += __shfl_xor(q, o);
        const float rstd = rsqrtf(q * (1.0f / 1024.0f) + 1e-5f);
        const int mr = row < TL ? (row >> 11) : 32;
        const float* sh = modl + (size_t)mr * 6144 + shoff + lane * 4;
#pragma unroll
        for (int i = 0; i < 4; ++i) {
            const f32x4 y = v[i] * rstd * gv[i] + bv[i];
            if (Xout) *(f32x4*)(Xout + (size_t)row * 1024 + i * 256 + lane * 4) = y;
            if (Dout && row < TL) *(f32x4*)(Dout + (size_t)row * 1024 + i * 256 + lane * 4) = y;
            if (H) {
                const f32x4 shv = *(const f32x4*)(sh + i * 256), scv = *(const f32x4*)(sh + 1024 + i * 256);
                const f32x4 h = y * (scv + 1.0f) + shv;
                u32x2 w; w.x = cvt_pk_bf16(h[0], h[1]); w.y = cvt_pk_bf16(h[2], h[3]);
                *(u32x2*)(H + (size_t)row * 1024 + i * 256 + lane * 4) = w;
            }
        }
    }
}

__device__ void gmlp_unit(LAS unsigned char* lds, const bf16_t* __restrict__ P, bf16_t* __restrict__ Y, const float* lng, const float* lnb, const bf16_t* __restrict__ Aws, const float* abs_, int row0) {
    const int tid = tid_opaque(), wid = __builtin_amdgcn_readfirstlane(tid >> 6), lane = tid & 63, fr = lane & 15, fq = lane >> 4;
    LAS bf16_t* vT = (LAS bf16_t*)lds;
    {
        const int tok = tid >> 2, qd = tid & 3;
        const bf16_t* vp = P + (size_t)(row0 + tok) * 2048 + 256 + qd * 64;
        u32x4 raw[8];
#pragma unroll
        for (int i = 0; i < 8; ++i) raw[i] = *(const u32x4*)(vp + i * 8);
        float s = 0.f;
#pragma unroll
        for (int i = 0; i < 8; ++i)
#pragma unroll
            for (int e = 0; e < 4; ++e) s += bflo(raw[i][e]) + bfhi(raw[i][e]);
        s += __shfl_xor(s, 1); s += __shfl_xor(s, 2);
        const float mean = s * (1.0f / 256.0f);
        float q = 0.f;
#pragma unroll
        for (int i = 0; i < 8; ++i)
#pragma unroll
            for (int e = 0; e < 4; ++e) { const float a = bflo(raw[i][e]) - mean, b = bfhi(raw[i][e]) - mean; q += a * a + b * b; }
        q += __shfl_xor(q, 1); q += __shfl_xor(q, 2);
        const float rstd = rsqrtf(q * (1.0f / 256.0f) + 1e-5f);
#pragma unroll
        for (int i = 0; i < 8; ++i)
#pragma unroll
            for (int e = 0; e < 4; ++e) {
                const int ch = qd * 64 + i * 8 + e * 2;
                const float a = (bflo(raw[i][e]) - mean) * rstd * lng[ch] + lnb[ch];
                const float b = (bfhi(raw[i][e]) - mean) * rstd * lng[ch + 1] + lnb[ch + 1];
                const unsigned w = cvt_pk_bf16(a, b);
                vT[ch * 136 + tok] = (bf16_t)(w & 0xffffu); vT[(ch + 1) * 136 + tok] = (bf16_t)(w >> 16);
            }
    }
    __syncthreads();
    const int g = wid >> 1, ih = wid & 1;
    f32x4 acc[4][4];
#pragma unroll
    for (int a = 0; a < 4; ++a)
#pragma unroll
        for (int b = 0; b < 4; ++b) acc[a][b] = (f32x4){0.f, 0.f, 0.f, 0.f};
#pragma unroll
    for (int ks = 0; ks < 4; ++ks) {
        bf16x8 wf[4], vf[4];
#pragma unroll
        for (int it = 0; it < 4; ++it) wf[it] = *(const bf16x8*)(Aws + (size_t)((g * 128 + ih * 64 + it * 16 + fr) * 128 + ks * 32 + fq * 8));
#pragma unroll
        for (int ct = 0; ct < 4; ++ct) vf[ct] = *(const LAS bf16x8*)(vT + (g * 64 + ct * 16 + fr) * 136 + ks * 32 + fq * 8);
#pragma unroll
        for (int it = 0; it < 4; ++it)
#pragma unroll
            for (int ct = 0; ct < 4; ++ct) acc[it][ct] = __builtin_amdgcn_mfma_f32_16x16x32_bf16(vf[ct], wf[it], acc[it][ct], 0, 0, 0);
    }
#pragma unroll
    for (int it = 0; it < 4; ++it) {
        const int i = ih * 64 + it * 16 + fr; const float bias = abs_[g * 128 + i];
#pragma unroll
        for (int ct = 0; ct < 4; ++ct) {
            const int c0 = g * 64 + ct * 16 + fq * 4;
            const u32x2 uu = *(const u32x2*)(P + (size_t)(row0 + i) * 2048 + c0);
            const f32x4 a = acc[it][ct];
            u32x2 w; w.x = cvt_pk_bf16(bflo(uu.x) * (a[0] + bias), bfhi(uu.x) * (a[1] + bias)); w.y = cvt_pk_bf16(bflo(uu.y) * (a[2] + bias), bfhi(uu.y) * (a[3] + bias));
            *(u32x2*)(Y + (size_t)(row0 + i) * 1024 + c0) = w;
        }
    }
    __syncthreads();
}

struct AttnState { f32x4 o[4][4]; float m[4], l[4]; };

template <int MASK>
__device__ __forceinline__ void attn_tile(const bf16_t* __restrict__ kptr, const bf16_t* __restrict__ vtp, int vstride, const bf16x8 (&qf)[4][2], AttnState& st, int fr, int fq,
                                          int marg  , const float* __restrict__ rpbrow  ) {
    bf16x8 kf[2][2];
#pragma unroll
    for (int kt = 0; kt < 2; ++kt)
#pragma unroll
        for (int kk = 0; kk < 2; ++kk) kf[kt][kk] = *(const bf16x8*)(kptr + (size_t)(kt * 16 + fr) * 2048 + kk * 32 + fq * 8);
    bf16x8 vf[4];
#pragma unroll
    for (int dt = 0; dt < 4; ++dt) {
        const bf16_t* vp = vtp + (size_t)(dt * 16 + fr) * vstride + fq * 4;
        const bf16x4 lo = *(const bf16x4*)vp, hi = *(const bf16x4*)(vp + 16);
        vf[dt] = (bf16x8){lo[0], lo[1], lo[2], lo[3], hi[0], hi[1], hi[2], hi[3]};
    }
    f32x4 s[2][4];
#pragma unroll
    for (int kt = 0; kt < 2; ++kt)
#pragma unroll
        for (int qt = 0; qt < 4; ++qt) {
            f32x4 a = (f32x4){0.f, 0.f, 0.f, 0.f};
#pragma unroll
            for (int kk = 0; kk < 2; ++kk) a = __builtin_amdgcn_mfma_f32_16x16x32_bf16(kf[kt][kk], qf[qt][kk], a, 0, 0, 0);
            s[kt][qt] = a;
        }
    bf16x8 pf[4];
#pragma unroll
    for (int qt = 0; qt < 4; ++qt) {
        float mx = -INFINITY;
#pragma unroll
        for (int kt = 0; kt < 2; ++kt)
#pragma unroll
            for (int j = 0; j < 4; ++j) {
                float v = s[kt][qt][j];
                if (MASK == 1) {
                    const int cq = qt * 16 + fr, kc = marg + kt * 16 + fq * 4 + j;
                    int cs = cq - 8; cs = cs < 0 ? 0 : (cs > 48 ? 48 : cs);
                    const bool ok = (kc >= cs) && (kc < cs + 16);
                    const float bias = ok ? rpbrow[kc - cq + 15] : 0.f;
                    v = ok ? (v + bias) : -INFINITY;
                } else if (MASK == 2) {
                    const int d = marg + kt * 16 + fq * 4 + j - (qt * 16 + fr);
                    v = (d >= -128 && d <= 128) ? v : -INFINITY;
                }
                v *= LOG2E; s[kt][qt][j] = v; mx = fmaxf(mx, v);
            }
        mx = fmaxf(mx, __shfl_xor(mx, 16)); mx = fmaxf(mx, __shfl_xor(mx, 32));
        const float mnew = fmaxf(st.m[qt], mx);
        const float muse = (mnew == -INFINITY) ? 0.f : mnew;
        const float alpha = fexp2(st.m[qt] - muse);
        st.m[qt] = mnew;
        float ps = 0.f;
#pragma unroll
        for (int kt = 0; kt < 2; ++kt)
#pragma unroll
            for (int j = 0; j < 4; ++j) { const float pv = fexp2(s[kt][qt][j] - muse); s[kt][qt][j] = pv; ps += pv; }
        st.l[qt] = st.l[qt] * alpha + ps;
#pragma unroll
        for (int dt = 0; dt < 4; ++dt) st.o[dt][qt] = st.o[dt][qt] * alpha;
        u32x4 w; w.x = cvt_pk_bf16(s[0][qt][0], s[0][qt][1]); w.y = cvt_pk_bf16(s[0][qt][2], s[0][qt][3]); w.z = cvt_pk_bf16(s[1][qt][0], s[1][qt][1]); w.w = cvt_pk_bf16(s[1][qt][2], s[1][qt][3]);
        pf[qt] = __builtin_bit_cast(bf16x8, w);
    }
#pragma unroll
    for (int dt = 0; dt < 4; ++dt)
#pragma unroll
        for (int qt = 0; qt < 4; ++qt) st.o[dt][qt] = __builtin_amdgcn_mfma_f32_16x16x32_bf16(vf[dt], pf[qt], st.o[dt][qt], 0, 0, 0);
}

__device__ void attn_unit(const Params& p, int layer, int u, int lane) {
    const int fr = lane & 15, fq = lane >> 4;
    const bf16_t* P = (const bf16_t*)(p.ws + OFF_P);
    bf16_t* Y = (bf16_t*)(p.ws + OFF_Y);
    int mode, b, qcol, kcol, ycol, qrow0; const bf16_t* vt_l = nullptr; const bf16_t* vt_c; float sink = 0.f; bool has_sink = false;
    int r = 0, rs = 0, q0 = 0, h = 0;
    if (u < 4096) {
        mode = 0; r = u & 31; h = (u >> 5) & 3; b = u >> 7; rs = r - 4; rs = rs < 0 ? 0 : (rs > 24 ? 24 : rs);
        qrow0 = b * 2048 + r * 64; qcol = 512 + h * 64; kcol = 768 + h * 64; ycol = 256 + h * 64;
        vt_l = (const bf16_t*)(p.ws + OFF_VTNA_L) + (size_t)((b * 4 + h) * 64) * 2048; vt_c = (const bf16_t*)(p.ws + OFF_VTNA_C) + (size_t)((b * 4 + h) * 64) * 256;
    } else if (u < 12288) {
        const int v = u - 4096; mode = 1; const int qb = v & 1, g = (v >> 1) & 3, qpair = (v >> 3) & 15, kv = (v >> 7) & 1; b = v >> 8;
        const int qh = kv * 4 + g; q0 = (qpair * 2 + qb) * 64;
        qrow0 = b * 2048 + q0; qcol = 1280 + qh * 64; kcol = 1792 + kv * 64; ycol = 512 + qh * 64;
        vt_l = (const bf16_t*)(p.ws + OFF_VTSW_L) + (size_t)((b * 2 + kv) * 64) * 2048; vt_c = (const bf16_t*)(p.ws + OFF_VTSW_C) + (size_t)((b * 2 + kv) * 64) * 256;
        sink = p.sw_sink[layer * 8 + qh]; has_sink = true;
    } else {
        const int v = u - 12288; mode = 2; const int qblk = v & 3, hh = (v >> 2) % 12; b = v / 48;
        qrow0 = TL + b * 256 + qblk * 64;
        if (hh < 4) { qcol = 512 + hh * 64; kcol = 768 + hh * 64; ycol = 256 + hh * 64; vt_c = (const bf16_t*)(p.ws + OFF_VTNA_C) + (size_t)((b * 4 + hh) * 64) * 256; }
        else { const int qh = hh - 4, kv = qh >> 2; qcol = 1280 + qh * 64; kcol = 1792 + kv * 64; ycol = 512 + qh * 64; vt_c = (const bf16_t*)(p.ws + OFF_VTSW_C) + (size_t)((b * 2 + kv) * 64) * 256; sink = p.sw_sink[layer * 8 + qh]; has_sink = true; }
    }
    bf16x8 qf[4][2];
#pragma unroll
    for (int qt = 0; qt < 4; ++qt)
#pragma unroll
        for (int kk = 0; kk < 2; ++kk) qf[qt][kk] = *(const bf16x8*)(P + (size_t)(qrow0 + qt * 16 + fr) * 2048 + qcol + kk * 32 + fq * 8);
    AttnState st;
#pragma unroll
    for (int qt = 0; qt < 4; ++qt) { st.m[qt] = -INFINITY; st.l[qt] = 0.f;
#pragma unroll
        for (int dt = 0; dt < 4; ++dt) st.o[dt][qt] = (f32x4){0.f, 0.f, 0.f, 0.f}; }
    if (mode == 0) {
        const float* rpb = p.na_rpb + (size_t)((layer * 4 + h) * 15) * 31;
        for (int t = 0; t < 16; ++t) {
            const int kr = rs + (t >> 1), cbk = (t & 1) * 32, key0 = kr * 64 + cbk;
            attn_tile<1>(P + (size_t)(b * 2048 + key0) * 2048 + kcol, vt_l + key0, 2048, qf, st, fr, fq, cbk, rpb + (kr - r + 7) * 31);
        }
    } else if (mode == 1) {
        const int ks = q0 - 128 < 0 ? 0 : q0 - 128, ke = q0 + 192 > 2048 ? 2048 : q0 + 192;
        for (int key0 = ks; key0 < ke; key0 += 32)
            attn_tile<2>(P + (size_t)(b * 2048 + key0) * 2048 + kcol, vt_l + key0, 2048, qf, st, fr, fq, key0 - q0, nullptr);
    }
    for (int t = 0; t < 8; ++t)
        attn_tile<0>(P + (size_t)(TL + b * 256 + t * 32) * 2048 + kcol, vt_c + t * 32, 256, qf, st, fr, fq, 0, nullptr);
#pragma unroll
    for (int qt = 0; qt < 4; ++qt) {
        float lt = st.l[qt]; lt += __shfl_xor(lt, 16); lt += __shfl_xor(lt, 32);
        if (has_sink) lt += fexp2(sink * LOG2E - st.m[qt]);
        const float inv = 1.0f / lt;
        bf16_t* yp = Y + (size_t)(qrow0 + qt * 16 + fr) * 1024 + ycol + fq * 4;
#pragma unroll
        for (int dt = 0; dt < 4; ++dt) {
            const f32x4 o = st.o[dt][qt] * inv;
            u32x2 w; w.x = cvt_pk_bf16(o[0], o[1]); w.y = cvt_pk_bf16(o[2], o[3]);
            *(u32x2*)(yp + dt * 16) = w;
        }
    }
}

__device__ void phase_mixer(const Params& p, LAS unsigned char* lds, int layer) {
    const bf16_t* P = (const bf16_t*)(p.ws + OFF_P);
    bf16_t* Y = (bf16_t*)(p.ws + OFF_Y);
    const int nchunks = layer == 0 ? (TT / 128) : (TL / 128);
    for (int cu = blockIdx.x; cu < nchunks; cu += gridDim.x)
        gmlp_unit(lds, P, Y, p.a_ln_g + layer * 256, p.a_ln_b + layer * 256, (const bf16_t*)(p.ws + OFF_AWS) + (size_t)layer * 4 * 128 * 128, p.a_bs + layer * 512, cu * 128);
    const int tid = tid_opaque(); const int lane = tid & 63, wid = __builtin_amdgcn_readfirstlane(tid >> 6);
    const int nunits = layer == 0 ? 13824 : 12288;
    for (int u = blockIdx.x * NWAVES + wid; u < nunits; u += gridDim.x * NWAVES) attn_unit(p, layer, u, lane);
}

__device__ __forceinline__ void gsync(unsigned* bar) {
    asm volatile("s_waitcnt vmcnt(0) lgkmcnt(0)" ::: "memory");
    __syncthreads();
    if (threadIdx.x == 0) {
        __builtin_amdgcn_fence(__ATOMIC_RELEASE, "agent");
        asm volatile("s_waitcnt vmcnt(0)" ::: "memory");
        __hip_atomic_fetch_add(bar, 1u, __ATOMIC_RELAXED, __HIP_MEMORY_SCOPE_AGENT);
        while (__hip_atomic_load(bar, __ATOMIC_RELAXED, __HIP_MEMORY_SCOPE_AGENT) < gridDim.x) __builtin_amdgcn_s_sleep(2);
    }
    __syncthreads();
    __builtin_amdgcn_fence(__ATOMIC_ACQUIRE, "agent");
    asm volatile("s_waitcnt vmcnt(0) lgkmcnt(0)" ::: "memory");
}
__global__ void __launch_bounds__(NTHREADS) fwd_megakernel(Params p) {
    extern __shared__ __attribute__((aligned(16))) unsigned char lds_raw[];
    LAS unsigned char* lds = (LAS unsigned char*)lds_raw;
    cg::grid_group grid = cg::this_grid();
    if (!grid.is_valid()) return;
    bf16_t* H = (bf16_t*)p.out;
    float* XZ = (float*)(p.ws + OFF_XZ);
    const float* mod = (const float*)(p.ws + OFF_MOD);
    bf16_t* Pb = (bf16_t*)(p.ws + OFF_P); bf16_t* Yb = (bf16_t*)(p.ws + OFF_Y); bf16_t* Ub = (bf16_t*)(p.ws + OFF_U);

    phase_prologue(p, lds);
    gsync((unsigned*)(p.ws + OFF_BAR) + 0);
    phase_modulate0(p, H);
    gsync((unsigned*)(p.ws + OFF_BAR) + 1);
#pragma unroll 1
    for (int l = 0; l < 2; ++l) {
        const float* modl = mod + (size_t)l * 33 * 6144;
        const int Mres = (l == 1) ? TL : TT;
        {   EpiIn e; e.P = Pb;
            e.rcos = (const float*)(p.ws + OFF_ROPE); e.rsin = e.rcos + 1024;
            gemm_phase(lds, H, (const bf16_t*)(p.ws + OFF_WIN) + (size_t)l * 2048 * 1024, TT, 2048, 1024, e); }
        gsync((unsigned*)(p.ws + OFF_BAR) + 2 + l * 8);
        phase_vtrans(p, lds);
        gsync((unsigned*)(p.ws + OFF_BAR) + 9 + l * 8);
        phase_mixer(p, lds, l);
        gsync((unsigned*)(p.ws + OFF_BAR) + 3 + l * 8);
        {   EpiRes e; e.res_lat = (l == 0) ? p.x : XZ; e.res_ctx = (l == 0) ? p.ctx : XZ + (size_t)TL * 1024; e.g = modl + 2048; e.out = XZ;
            gemm_phase(lds, Yb, (const bf16_t*)(p.ws + OFF_WOUT) + (size_t)l * 1024 * 1024, Mres, 1024, 1024, e); }
        gsync((unsigned*)(p.ws + OFF_BAR) + 4 + l * 8);
        phase_ln(XZ, Mres, p.ln1_g + l * 1024, p.ln1_b + l * 1024, XZ, nullptr, H, modl, 3072);
        gsync((unsigned*)(p.ws + OFF_BAR) + 5 + l * 8);
        {   EpiRelu2 e; e.U = Ub;
            gemm_phase(lds, H, (const bf16_t*)(p.ws + OFF_W1) + (size_t)l * 4096 * 1024, Mres, 4096, 1024, e); }
        gsync((unsigned*)(p.ws + OFF_BAR) + 6 + l * 8);
        {   EpiRes e; e.res_lat = XZ; e.res_ctx = XZ + (size_t)TL * 1024; e.g = modl + 5120; e.out = XZ;
            gemm_phase(lds, Ub, (const bf16_t*)(p.ws + OFF_W2) + (size_t)l * 1024 * 4096, Mres, 1024, 4096, e); }
        gsync((unsigned*)(p.ws + OFF_BAR) + 7 + l * 8);
        if (l == 0) { phase_ln(XZ, Mres, p.ln2_g, p.ln2_b, XZ, nullptr, H, mod + (size_t)33 * 6144, 0); gsync((unsigned*)(p.ws + OFF_BAR) + 8 + l * 8); }
        else phase_ln(XZ, Mres, p.ln2_g + 1024, p.ln2_b + 1024, nullptr, p.out, nullptr, modl, 0);
    }
}

extern "C" void kernel_launch(void* const* d_in, const int* in_sizes, int n_in, void* d_out, int out_size, void* d_ws, size_t ws_size, hipStream_t stream) {
    static int grid_blocks = 0;
    if (grid_blocks == 0) {
        if (n_in != 20 || out_size != TL * DM || ws_size < WS_END) { fprintf(stderr, "kernel_launch: unexpected shapes (n_in %d, out %d, ws %zu, need %zu)\n", n_in, out_size, ws_size, (size_t)WS_END); grid_blocks = -1; return; }
        int dev = 0, cus = 0, per_cu = 0;
        hipGetDevice(&dev);
        hipDeviceGetAttribute(&cus, hipDeviceAttributeMultiprocessorCount, dev);
        if (hipFuncSetAttribute((const void*)fwd_megakernel, hipFuncAttributeMaxDynamicSharedMemorySize, LDS_BYTES) != hipSuccess) { fprintf(stderr, "kernel_launch: hipFuncSetAttribute failed\n"); grid_blocks = -1; return; }
        if (hipOccupancyMaxActiveBlocksPerMultiprocessor(&per_cu, (const void*)fwd_megakernel, NTHREADS, LDS_BYTES) != hipSuccess || per_cu < 1) { fprintf(stderr, "kernel_launch: occupancy query gave %d\n", per_cu); per_cu = 1; }
        (void)hipGetLastError();
        grid_blocks = cus * per_cu;
    }
    if (grid_blocks < 0) return;
    Params p{};
    const float** f = (const float**)&p;
    for (int i = 0; i < 20; ++i) f[i] = (const float*)d_in[i];
    p.out = (float*)d_out; p.ws = (unsigned char*)d_ws;
    if (hipMemsetAsync((unsigned char*)d_ws + OFF_BAR, 0, 256, stream) != hipSuccess) { fprintf(stderr, "kernel_launch: memset failed\n"); return; }
    void* args[] = {&p};
    hipError_t e = hipLaunchCooperativeKernel((const void*)fwd_megakernel, dim3(grid_blocks), dim3(NTHREADS), args, LDS_BYTES, stream);
    if (e != hipSuccess) fprintf(stderr, "cooperative launch failed: %s (grid %d)\n", hipGetErrorString(e), grid_blocks);
}
```

```cpp
#include <hip/hip_runtime.h>
#include <hip/hip_cooperative_groups.h>
#include <cstdio>
#include <cstdint>
namespace cg = cooperative_groups;

typedef unsigned short bf16_t;
typedef short bf16x8 __attribute__((ext_vector_type(8)));
typedef short bf16x4 __attribute__((ext_vector_type(4)));
typedef float f32x4 __attribute__((ext_vector_type(4)));
typedef unsigned u32x2 __attribute__((ext_vector_type(2)));
typedef unsigned u32x4 __attribute__((ext_vector_type(4)));
#define LAS __attribute__((address_space(3)))

constexpr int DM = 1024, NB = 32, SEQ = 2048, CTXL = 256, TL = NB * SEQ, TC = NB * CTXL, TT = TL + TC, DFF = 4096, INW = 2048;
constexpr int NTHREADS = 512, NWAVES = 8;
constexpr int LDS_BYTES = 136 * 1024;
constexpr float ALPHA = 1.41421356237f;
constexpr float LOG2E = 1.4426950408889634f;

constexpr size_t OFF_WIN = 0;
constexpr size_t OFF_WOUT = OFF_WIN + 2ull * 2048 * 1024 * 2;
constexpr size_t OFF_W1 = OFF_WOUT + 2ull * 1024 * 1024 * 2;
constexpr size_t OFF_W2 = OFF_W1 + 2ull * 4096 * 1024 * 2;
constexpr size_t OFF_AWS = OFF_W2 + 2ull * 4096 * 1024 * 2;
constexpr size_t OFF_MOD = OFF_AWS + 2ull * 4 * 128 * 128 * 2;
constexpr size_t OFF_ROPE = OFF_MOD + 2ull * 33 * 6144 * 4;
constexpr size_t OFF_BAR = OFF_ROPE + 8192;
constexpr size_t OFF_XZ = OFF_BAR + 256;
constexpr size_t OFF_H = OFF_XZ + (size_t)TT * 1024 * 2;
constexpr size_t OFF_U = OFF_H + (size_t)TT * 1024 * 2;
constexpr size_t WS_END = OFF_U + (size_t)TT * 4096 * 2;
constexpr size_t OFF_P = OFF_U;
constexpr size_t OFF_Y = OFF_P + (size_t)TT * 2048 * 2;
constexpr size_t OFF_VTNA_L = OFF_Y + (size_t)TT * 1024 * 2;
constexpr size_t OFF_VTNA_C = OFF_VTNA_L + (size_t)NB * 4 * 64 * 2048 * 2;
constexpr size_t OFF_VTSW_L = OFF_VTNA_C + (size_t)NB * 4 * 64 * 256 * 2;
constexpr size_t OFF_VTSW_C = OFF_VTSW_L + (size_t)NB * 2 * 64 * 2048 * 2;
static_assert(OFF_VTSW_C + (size_t)NB * 2 * 64 * 256 * 2 <= WS_END, "overlay");

struct Params {
    const float *x, *c, *ctx, *c_ctx, *w_mod, *b_mod, *w_in, *a_ln_g, *a_ln_b, *a_ws, *a_bs, *na_rpb, *sw_sink, *w_out, *ln1_g, *ln1_b, *w1, *w2, *ln2_g, *ln2_b;
    float* out;
    unsigned char* ws;
};

typedef float f32x2 __attribute__((ext_vector_type(2)));
typedef __bf16 bf16v2 __attribute__((ext_vector_type(2)));
__device__ __forceinline__ unsigned cvt_pk_bf16(float lo, float hi) { f32x2 v = {lo, hi}; bf16v2 r = __builtin_convertvector(v, bf16v2); return __builtin_bit_cast(unsigned, r); }
__device__ __forceinline__ float bf2f(unsigned short v) { return __uint_as_float(((unsigned)v) << 16); }
__device__ __forceinline__ float bflo(unsigned v) { return __uint_as_float(v << 16); }
__device__ __forceinline__ float bfhi(unsigned v) { return __uint_as_float(v & 0xffff0000u); }
__device__ __forceinline__ float fexp2(float v) { return __builtin_amdgcn_exp2f(v); }
__device__ __forceinline__ int tid_opaque() { int t = threadIdx.x; asm volatile("" : "+v"(t)); return t; }

namespace pg8 {
#define PG8_LAS __attribute__((address_space(3)))
typedef unsigned short bf16_t;
typedef short bf16x8 __attribute__((ext_vector_type(8)));
typedef float f32x4 __attribute__((ext_vector_type(4)));
typedef unsigned u32x4 __attribute__((ext_vector_type(4)));
constexpr int BM = 256, BK = 64, HALF = 128, HTB = HALF * BK * 2  , STAGE_BYTES = 8 * HTB, NXCD = 8, WGM = 8;

__host__ __device__ __forceinline__ int lds_byte(int r, int c) { const int st = (r >> 4) * 2 + (c >> 5), rr = r & 15, cc = c & 31, ob = rr * 64 + cc * 2; return st * 1024 + (ob ^ (((ob >> 9) & 1) << 5)); }
__host__ __device__ __forceinline__ void stage_rc(int b, int& R, int& C) { const int st = b / 1024, sb = b % 1024, swz = sb ^ (((sb >> 9) & 1) << 5); R = (st >> 1) * 16 + swz / 64; C = (st & 1) * 32 + (swz % 64) / 2; }
__host__ __device__ __forceinline__ int perm32(int rho) { const int n = rho >> 4, i = rho & 15; return 8 * (i >> 2) + 4 * n + (i & 3); }

struct Unit { int pm, pn; };
struct Gemm { const bf16_t* A; const bf16_t* Bt; int M, N, K; };

struct StaticOrder {
    int nM, nN, nwg, G, c;
    __host__ __device__ void init(int M, int N, int G_, int c_) { nM = M / BM; nN = N / BM; nwg = nM * nN; G = G_; c = c_; }
    __host__ __device__ bool next(int i, Unit& u) const {
        const long L = (long)i * G + c; if (L >= nwg) return false;
        int wgid = (int)L; { const int q = nwg / NXCD, r = nwg % NXCD, xcd = wgid % NXCD, off = wgid / NXCD; wgid = (xcd < r ? xcd * (q + 1) : r * (q + 1) + (xcd - r) * q) + off; }
        const int nig = WGM * nN, gid = wgid / nig, fm = gid * WGM, gsz = (nM - fm) < WGM ? (nM - fm) : WGM;
        u.pm = fm + ((wgid % nig) % gsz); u.pn = (wgid % nig) / gsz; return true;
    }
    __device__ __forceinline__ void a_ready(const Unit&) const {}
    __device__ __forceinline__ void done(const Unit&) const {}
};
template <class Epi, class Sched, bool ALIGN_EPI = false, bool SP2 = false>
__device__ __forceinline__ void gemm_phase(PG8_LAS unsigned char* lds, const Gemm g, const Sched& S, const Epi& E) {
    const int tid = tid_opaque(), wid = __builtin_amdgcn_readfirstlane(tid >> 6), lane = tid & 63, wr = wid >> 2, wc = wid & 3, fr = lane & 15, fq = lane >> 4;
    const int K = g.K, nt = K / BK;
    unsigned voffA[2], voffB[2];
#pragma unroll
    for (int i = 0; i < 2; ++i) { int R, C; stage_rc(tid * 16 + i * 8192, R, C); const int Rb = Epi::PERM ? ((R & ~31) + perm32(R & 31)) : R;
        voffA[i] = (unsigned)(R * K + C) * 2u; voffB[i] = (unsigned)(Rb * K + C) * 2u; }
    const size_t kstep = (size_t)(BK * 2);
    const size_t hstep = (size_t)HALF * K * 2;
    const size_t tstep = 2 * hstep;
    const unsigned ldsw = (unsigned)wid * 1024u;
    const int aoff = lds_byte(wr * 64 + fr, fq * 8), boff = lds_byte(wc * 32 + fr, fq * 8);
#define PG8_SA(b, h) (((b) * 2 + (h)) * HTB)
#define PG8_SB(b, h) ((4 + (b) * 2 + (h)) * HTB)
#define PG8_STAGE(bufoff, gbase, voff) do { _Pragma("unroll") for (int _i = 0; _i < 2; ++_i) \
        __builtin_amdgcn_global_load_lds((const unsigned*)((const char*)(gbase) + (voff)[_i]), (PG8_LAS unsigned*)(lds + (bufoff) + ldsw + _i * 8192), 16, 0, 0); } while (0)
#define PG8_LDA(dst, b, h) do { _Pragma("unroll") for (int m = 0; m < 4; ++m) _Pragma("unroll") for (int k = 0; k < 2; ++k) dst[m][k] = *(const PG8_LAS bf16x8*)(lds + PG8_SA(b, h) + aoff + m * 2048 + k * 1024); } while (0)
#define PG8_LDB(dst, b, h) do { _Pragma("unroll") for (int n = 0; n < 2; ++n) _Pragma("unroll") for (int k = 0; k < 2; ++k) dst[n][k] = *(const PG8_LAS bf16x8*)(lds + PG8_SB(b, h) + boff + n * 2048 + k * 1024); } while (0)
#define PG8_MMA(ai, bj, At, Bt) do { __builtin_amdgcn_s_setprio(1); _Pragma("unroll") for (int m = 0; m < 4; ++m) _Pragma("unroll") for (int n = 0; n < 2; ++n) _Pragma("unroll") for (int k = 0; k < 2; ++k) \
        acc[ai][bj][m][n] = __builtin_amdgcn_mfma_f32_16x16x32_bf16(Bt[n][k], At[m][k], acc[ai][bj][m][n], 0, 0, 0); __builtin_amdgcn_s_setprio(0); } while (0)
#define PG8_WAIT_V(n) asm volatile("s_waitcnt vmcnt(" #n ")" ::: "memory")
#define PG8_WAIT_L(n) asm volatile("s_waitcnt lgkmcnt(" #n ")" ::: "memory")
#define PG8_BAR __builtin_amdgcn_s_barrier()
#define PG8_SCHED __builtin_amdgcn_sched_barrier(0)
    Unit cur, nxt; int ui = 0;
    if (!S.next(0, cur)) return;
    f32x4 acc[2][2][4][2];
#pragma unroll
    for (int a = 0; a < 2; ++a)
#pragma unroll
        for (int b = 0; b < 2; ++b)
#pragma unroll
            for (int m = 0; m < 4; ++m)
#pragma unroll
                for (int n = 0; n < 2; ++n) acc[a][b][m][n] = (f32x4){0.f, 0.f, 0.f, 0.f};
    bf16x8 At[4][2], B0[2][2], B1[2][2];
    const char* cA = (const char*)g.A + (size_t)cur.pm * tstep; const char* cB = (const char*)g.Bt + (size_t)cur.pn * tstep;
    S.a_ready(cur);
    if constexpr (SP2) {
        PG8_STAGE(PG8_SB(0, 0), cB, voffB); PG8_STAGE(PG8_SB(0, 1), cB + hstep, voffB); PG8_STAGE(PG8_SA(0, 0), cA, voffA); PG8_STAGE(PG8_SA(0, 1), cA + hstep, voffA);
        if (wr == 1) PG8_BAR;
        PG8_WAIT_V(2); PG8_BAR;
        PG8_STAGE(PG8_SB(1, 0), cB + kstep, voffB); PG8_STAGE(PG8_SA(1, 0), cA + kstep, voffA); PG8_STAGE(PG8_SB(1, 1), cB + hstep + kstep, voffB);
        PG8_WAIT_V(6); PG8_BAR;
    } else {
        PG8_STAGE(PG8_SB(0, 0), cB, voffB); PG8_STAGE(PG8_SA(0, 0), cA, voffA); PG8_STAGE(PG8_SB(0, 1), cB + hstep, voffB); PG8_STAGE(PG8_SA(0, 1), cA + hstep, voffA);
        if (wr == 1) PG8_BAR;
        PG8_WAIT_V(4); PG8_BAR;
        PG8_STAGE(PG8_SB(1, 0), cB + kstep, voffB); PG8_STAGE(PG8_SA(1, 0), cA + kstep, voffA); PG8_STAGE(PG8_SB(1, 1), cB + hstep + kstep, voffB);
        PG8_WAIT_V(6); PG8_BAR;
    }
    for (;;) {
        const bool has_next = S.next(ui + 1, nxt);
        const char* nA = has_next ? (const char*)g.A + (size_t)nxt.pm * tstep : cA; const char* nB = has_next ? (const char*)g.Bt + (size_t)nxt.pn * tstep : cB;
        for (int t = 0; t < nt; t += 2) {
            const bool last = (t == nt - 2);
            const char* a1 = cA + (size_t)(t + 1) * kstep;
            const char* a2 = last ? nA : cA + (size_t)(t + 2) * kstep; const char* b2 = last ? nB : cB + (size_t)(t + 2) * kstep;
            const char* a3 = a2 + kstep; const char* b3 = b2 + kstep;
            if (last && has_next) S.a_ready(nxt);
            if constexpr (SP2) {
            PG8_LDB(B0, 0, 0); PG8_LDB(B1, 0, 1); PG8_SCHED; PG8_LDA(At, 0, 0); PG8_STAGE(PG8_SA(1, 1), a1 + hstep, voffA);
            PG8_WAIT_V(8); PG8_WAIT_L(0); PG8_BAR; PG8_MMA(0, 0, At, B0); PG8_MMA(0, 1, At, B1); PG8_BAR; PG8_SCHED;
            PG8_LDA(At, 0, 1); PG8_STAGE(PG8_SB(0, 0), b2, voffB); PG8_STAGE(PG8_SB(0, 1), b2 + hstep, voffB); PG8_STAGE(PG8_SA(0, 0), a2, voffA);
            PG8_WAIT_V(8); PG8_WAIT_L(0); PG8_BAR; PG8_MMA(1, 0, At, B0); PG8_MMA(1, 1, At, B1); PG8_BAR; PG8_SCHED;
            PG8_LDB(B0, 1, 0); PG8_LDB(B1, 1, 1); PG8_SCHED; PG8_LDA(At, 1, 0); PG8_STAGE(PG8_SA(0, 1), a2 + hstep, voffA);
            PG8_WAIT_V(8); PG8_WAIT_L(0); PG8_BAR; PG8_MMA(0, 0, At, B0); PG8_MMA(0, 1, At, B1); PG8_BAR; PG8_SCHED;
            PG8_LDA(At, 1, 1); PG8_STAGE(PG8_SB(1, 0), b3, voffB); PG8_STAGE(PG8_SB(1, 1), b3 + hstep, voffB); PG8_STAGE(PG8_SA(1, 0), a3, voffA);
            PG8_WAIT_V(8); PG8_WAIT_L(0); PG8_BAR; PG8_MMA(1, 0, At, B0); PG8_MMA(1, 1, At, B1); PG8_BAR; PG8_SCHED;
            } else {
            PG8_LDB(B0, 0, 0); PG8_SCHED; PG8_LDA(At, 0, 0); PG8_STAGE(PG8_SA(1, 1), a1 + hstep, voffA);
            PG8_WAIT_L(8); PG8_BAR; PG8_WAIT_L(0); PG8_MMA(0, 0, At, B0); PG8_BAR; PG8_SCHED;
            PG8_LDB(B1, 0, 1); PG8_STAGE(PG8_SB(0, 0), b2, voffB);
            PG8_BAR; PG8_WAIT_L(0); PG8_MMA(0, 1, At, B1); PG8_BAR;
            PG8_LDA(At, 0, 1); PG8_STAGE(PG8_SA(0, 0), a2, voffA);
            PG8_BAR; PG8_WAIT_L(0); PG8_MMA(1, 0, At, B0); PG8_BAR; PG8_SCHED;
            PG8_STAGE(PG8_SB(0, 1), b2 + hstep, voffB);
            PG8_WAIT_V(6); PG8_BAR; PG8_MMA(1, 1, At, B1); PG8_BAR;
            PG8_LDB(B0, 1, 0); PG8_SCHED; PG8_LDA(At, 1, 0); PG8_STAGE(PG8_SA(0, 1), a2 + hstep, voffA);
            PG8_WAIT_L(8); PG8_BAR; PG8_WAIT_L(0); PG8_MMA(0, 0, At, B0); PG8_BAR; PG8_SCHED;
            PG8_LDB(B1, 1, 1); PG8_STAGE(PG8_SB(1, 0), b3, voffB);
            PG8_BAR; PG8_WAIT_L(0); PG8_MMA(0, 1, At, B1); PG8_BAR;
            PG8_LDA(At, 1, 1); PG8_STAGE(PG8_SA(1, 0), a3, voffA);
            PG8_BAR; PG8_WAIT_L(0); PG8_MMA(1, 0, At, B0); PG8_BAR; PG8_SCHED;
            PG8_STAGE(PG8_SB(1, 1), b3 + hstep, voffB);
            PG8_WAIT_V(6); PG8_BAR; PG8_MMA(1, 1, At, B1); PG8_BAR;
            }
        }
        if constexpr (ALIGN_EPI) { if (wr == 0) PG8_BAR; }
        if constexpr (!Epi::AFTER_DRAIN) { E(acc, cur, wr, wc, fr, fq); S.done(cur); }
        if (!has_next) break;
#pragma unroll
        for (int a = 0; a < 2; ++a)
#pragma unroll
            for (int b = 0; b < 2; ++b)
#pragma unroll
                for (int m = 0; m < 4; ++m)
#pragma unroll
                    for (int n = 0; n < 2; ++n) acc[a][b][m][n] = (f32x4){0.f, 0.f, 0.f, 0.f};
        cur = nxt; cA = nA; cB = nB; ++ui;
        if constexpr (ALIGN_EPI) { if (wr == 1) PG8_BAR; }
    }
    PG8_WAIT_V(0);
    if constexpr (!ALIGN_EPI) { if (wr == 0) PG8_BAR; }
    PG8_BAR;
    if constexpr (Epi::AFTER_DRAIN) { E.fused(acc, cur, wr, wc, fr, fq, lds, wid, lane); S.done(cur); }
#undef PG8_SA
#undef PG8_SB
#undef PG8_STAGE
#undef PG8_LDA
#undef PG8_LDB
#undef PG8_MMA
#undef PG8_WAIT_V
#undef PG8_WAIT_L
#undef PG8_BAR
#undef PG8_SCHED
}
}

using pg8::Unit;
__device__ __forceinline__ float gelu_tanh(float v) {
    const float u = 0.7978845608028654f * (v + 0.044715f * v * v * v);
    return v / (1.0f + __expf(-2.0f * u));
}

struct EpiIn {
    static constexpr bool PERM = false, AFTER_DRAIN = false;
    bf16_t* P; const float* rcos; const float* rsin;
    __device__ __forceinline__ void operator()(const f32x4 (&acc)[2][2][4][2], const Unit& u, int wr, int wc, int fr, int fq) const {
#pragma unroll
        for (int bj = 0; bj < 2; ++bj) {
            const int cg = u.pn * 256 + bj * 128 + wc * 32;
            const bool lat = u.pm * 256 < TL;
            const int emode = cg < 512 ? 1 : ((cg >= 1280 && cg < 1920 && lat) ? 2 : 0);
            const float sc = ((cg >= 512 && cg < 768) || (cg >= 1280 && cg < 1792)) ? 0.125f : 1.0f;
            const bool colrot = (cg & 32) != 0;
#pragma unroll
            for (int ai = 0; ai < 2; ++ai)
#pragma unroll
                for (int m = 0; m < 4; ++m) {
                    const int row = u.pm * 256 + ai * 128 + wr * 64 + m * 16 + fr;
                    f32x4 v0 = acc[ai][bj][m][0], v1 = acc[ai][bj][m][1];
                    if (emode == 1) {
#pragma unroll
                        for (int j = 0; j < 4; ++j) { v0[j] = gelu_tanh(v0[j]); v1[j] = gelu_tanh(v1[j]); }
                    } else if (emode == 2) {
                        const int s = row & 2047; const int pos = colrot ? (s & 63) : (s >> 6);
                        const f32x4 c = *(const f32x4*)(rcos + pos * 16 + 4 * fq), sn = *(const f32x4*)(rsin + pos * 16 + 4 * fq);
                        const f32x4 a0 = v0, a1 = v1;
                        v0 = a0 * c - a1 * sn; v1 = a0 * sn + a1 * c;
                    }
                    bf16_t* rowp = P + (size_t)row * 2048 + cg + 4 * fq;
                    u32x2 w;
                    w.x = cvt_pk_bf16(v0[0] * sc, v0[1] * sc); w.y = cvt_pk_bf16(v0[2] * sc, v0[3] * sc); *(u32x2*)(rowp) = w;
                    w.x = cvt_pk_bf16(v1[0] * sc, v1[1] * sc); w.y = cvt_pk_bf16(v1[2] * sc, v1[3] * sc); *(u32x2*)(rowp + 16) = w;
                }
        }
    }
};

struct EpiRes {
    static constexpr bool PERM = false, AFTER_DRAIN = false;
    const float* res_lat; const float* res_ctx; const bf16_t* resb; const float* g; bf16_t* out;
    __device__ __forceinline__ void operator()(const f32x4 (&acc)[2][2][4][2], const Unit& u, int wr, int wc, int fr, int fq) const {
        const int rowt = u.pm * 256;
        const int mr = rowt < TL ? (rowt >> 11) : 32;
        const int c0 = u.pn * 256 + wc * 32 + 4 * fq;
        const float* gp = g + (size_t)mr * 6144 + c0;
        f32x4 gg[2][2];
#pragma unroll
        for (int bj = 0; bj < 2; ++bj)
#pragma unroll
            for (int n = 0; n < 2; ++n) gg[bj][n] = *(const f32x4*)(gp + bj * 128 + n * 16);
        const float* rbase = rowt < TL ? res_lat + (size_t)rowt * 1024 : res_ctx + (size_t)(rowt - TL) * 1024;
#pragma unroll
        for (int ai = 0; ai < 2; ++ai)
#pragma unroll
            for (int m = 0; m < 4; ++m) {
                const int rl = ai * 128 + wr * 64 + m * 16 + fr;
                bf16_t* op = out + (size_t)(rowt + rl) * 1024 + c0;
#pragma unroll
                for (int bj = 0; bj < 2; ++bj)
#pragma unroll
                    for (int n = 0; n < 2; ++n) {
                        f32x4 r;
                        if (resb) { const u32x2 rb = *(const u32x2*)(resb + (size_t)(rowt + rl) * 1024 + c0 + bj * 128 + n * 16); r = (f32x4){bflo(rb.x), bfhi(rb.x), bflo(rb.y), bfhi(rb.y)}; }
                        else r = *(const f32x4*)(rbase + (size_t)rl * 1024 + c0 + bj * 128 + n * 16);
                        const f32x4 z = r * ALPHA + gg[bj][n] * acc[ai][bj][m][n];
                        u32x2 w; w.x = cvt_pk_bf16(z[0], z[1]); w.y = cvt_pk_bf16(z[2], z[3]);
                        *(u32x2*)(op + bj * 128 + n * 16) = w;
                    }
            }
    }
};

struct EpiRelu2 {
    static constexpr bool PERM = true, AFTER_DRAIN = false;
    bf16_t* U;
    __device__ __forceinline__ void operator()(const f32x4 (&acc)[2][2][4][2], const Unit& u, int wr, int wc, int fr, int fq) const {
        const int c0 = u.pn * 256 + wc * 32 + 8 * fq;
#pragma unroll
        for (int ai = 0; ai < 2; ++ai)
#pragma unroll
            for (int m = 0; m < 4; ++m) {
                bf16_t* rowp = U + (size_t)(u.pm * 256 + ai * 128 + wr * 64 + m * 16 + fr) * 4096 + c0;
#pragma unroll
                for (int bj = 0; bj < 2; ++bj) {
                    f32x4 v0 = acc[ai][bj][m][0], v1 = acc[ai][bj][m][1];
#pragma unroll
                    for (int j = 0; j < 4; ++j) { const float t0 = fmaxf(v0[j], 0.f), t1 = fmaxf(v1[j], 0.f); v0[j] = t0 * t0; v1[j] = t1 * t1; }
                    u32x4 w; w.x = cvt_pk_bf16(v0[0], v0[1]); w.y = cvt_pk_bf16(v0[2], v0[3]); w.z = cvt_pk_bf16(v1[0], v1[1]); w.w = cvt_pk_bf16(v1[2], v1[3]);
                    *(u32x4*)(rowp + bj * 128) = w;
                }
            }
    }
};

template <class Epi>
__device__ __forceinline__ void gemm_phase(LAS unsigned char* lds, const bf16_t* A, const bf16_t* Bt, int M, int N, int K, const Epi& epi) {
    pg8::Gemm g; g.A = A; g.Bt = Bt; g.M = M; g.N = N; g.K = K;
    pg8::StaticOrder so; so.init(M, N, (int)gridDim.x, (int)blockIdx.x);
    pg8::gemm_phase<Epi, pg8::StaticOrder, true, true>(lds, g, so, epi);
}

__device__ void phase_vtrans(const Params& p, LAS unsigned char* lds) {
    const int tid = tid_opaque(); const int lane = tid & 63, wid = __builtin_amdgcn_readfirstlane(tid >> 6);
    LAS bf16_t* sl = (LAS bf16_t*)(lds + wid * 9216);
    const bf16_t* P = (const bf16_t*)(p.ws + OFF_P);
    for (int u = blockIdx.x * NWAVES + wid; u < 6144 + 768; u += gridDim.x * NWAVES) {
        int b, hd, tile, row0, stride;
        if (u < 6144) { tile = u & 31; hd = (u >> 5) % 6; b = u / 192; row0 = b * 2048 + tile * 64; stride = 2048; }
        else { const int v = u - 6144; tile = v & 3; hd = (v >> 2) % 6; b = v / 24; row0 = TL + b * 256 + tile * 64; stride = 256; }
        const int vcol = hd < 4 ? 1024 + hd * 64 : 1920 + (hd - 4) * 64;
        const size_t off = u < 6144 ? (hd < 4 ? OFF_VTNA_L : OFF_VTSW_L) : (hd < 4 ? OFF_VTNA_C : OFF_VTSW_C);
        const int hh = hd < 4 ? (b * 4 + hd) : (b * 2 + hd - 4);
        bf16_t* dst = (bf16_t*)(p.ws + off) + (size_t)(hh * 64) * stride + tile * 64;
        const bf16_t* src = P + (size_t)(row0 + lane) * 2048 + vcol;
#pragma unroll
        for (int i = 0; i < 8; ++i) *(LAS u32x4*)(sl + lane * 72 + i * 8) = *(const u32x4*)(src + i * 8);
        asm volatile("s_waitcnt vmcnt(0) lgkmcnt(0)" ::: "memory");
#pragma unroll
        for (int i = 0; i < 8; ++i) {
            u32x4 w;
#pragma unroll
            for (int e = 0; e < 4; ++e) { const unsigned lo = sl[(i * 8 + 2 * e) * 72 + lane], hi = sl[(i * 8 + 2 * e + 1) * 72 + lane]; w[e] = lo | (hi << 16); }
            *(u32x4*)(dst + (size_t)lane * stride + i * 8) = w;
        }
        asm volatile("s_waitcnt lgkmcnt(0)" ::: "memory");
    }
}

__device__ __forceinline__ void transpose_tile(const float* __restrict__ src, bf16_t* __restrict__ dst, int K, int N, int kb, int nb, LAS float* lt) {
    const int tid = tid_opaque();
    { const int n = tid & 63, k0 = tid >> 6;
#pragma unroll
      for (int i = 0; i < 8; ++i) { const int k = k0 + 8 * i; lt[k * 65 + n] = src[(size_t)(kb + k) * N + nb + n]; } }
    __syncthreads();
    { const int kp = tid & 31, n0 = tid >> 5;
#pragma unroll
      for (int i = 0; i < 4; ++i) { const int n = n0 + 16 * i; const unsigned w = cvt_pk_bf16(lt[(2 * kp) * 65 + n], lt[(2 * kp + 1) * 65 + n]); *(unsigned*)(dst + (size_t)(nb + n) * K + kb + 2 * kp) = w; } }
    __syncthreads();
}

__device__ void phase_prologue(const Params& p, LAS unsigned char* lds) {
    const int tid = tid_opaque();
    LAS float* lf = (LAS float*)lds;
    for (int u = blockIdx.x; u < 192; u += gridDim.x) {
        const int l = u / 96, nb = (u % 96) * 64;
        for (int idx = tid; idx < 33 * 1024; idx += NTHREADS) { const int r = idx >> 10, k = idx & 1023; const float v = r < 32 ? p.c[r * 1024 + k] : p.c_ctx[k]; lf[idx] = v / (1.0f + __expf(-v)); }
        __syncthreads();
        const int n = tid & 63, s = __builtin_amdgcn_readfirstlane(tid >> 6);
        float acc[33];
#pragma unroll
        for (int r = 0; r < 33; ++r) acc[r] = 0.f;
        const float* wp = p.w_mod + ((size_t)l * 1024 + s * 128) * 6144 + nb + n;
        for (int k = 0; k < 128; ++k) {
            const float w = wp[(size_t)k * 6144];
            const LAS float* sp = lf + s * 128 + k;
#pragma unroll
            for (int r = 0; r < 33; ++r) acc[r] += sp[r * 1024] * w;
        }
        __syncthreads();
#pragma unroll
        for (int r = 0; r < 33; ++r) lf[(s * 33 + r) * 64 + n] = acc[r];
        __syncthreads();
        for (int idx = tid; idx < 33 * 64; idx += NTHREADS) {
            const int r = idx >> 6, nn = idx & 63; float sum = p.b_mod[l * 6144 + nb + nn];
#pragma unroll
            for (int ss = 0; ss < 8; ++ss) sum += lf[(ss * 33 + r) * 64 + nn];
            ((float*)(p.ws + OFF_MOD))[((size_t)l * 33 + r) * 6144 + nb + nn] = sum;
        }
        __syncthreads();
    }
    for (int u = blockIdx.x; u < 2 * 2816; u += gridDim.x) {
        const int l = u / 2816; int r = u % 2816;
        if (r < 512) { const int kb = (r >> 5) * 64, nb = (r & 31) * 64; transpose_tile(p.w_in + (size_t)l * 1024 * 2048, (bf16_t*)(p.ws + OFF_WIN) + (size_t)l * 2048 * 1024, 1024, 2048, kb, nb, lf); }
        else if (r < 768) { r -= 512; const int kb = (r >> 4) * 64, nb = (r & 15) * 64; transpose_tile(p.w_out + (size_t)l * 1024 * 1024, (bf16_t*)(p.ws + OFF_WOUT) + (size_t)l * 1024 * 1024, 1024, 1024, kb, nb, lf); }
        else if (r < 1792) { r -= 768; const int kb = (r >> 6) * 64, nb = (r & 63) * 64; transpose_tile(p.w1 + (size_t)l * 1024 * 4096, (bf16_t*)(p.ws + OFF_W1) + (size_t)l * 4096 * 1024, 1024, 4096, kb, nb, lf); }
        else { r -= 1792; const int kb = (r >> 4) * 64, nb = (r & 15) * 64; transpose_tile(p.w2 + (size_t)l * 4096 * 1024, (bf16_t*)(p.ws + OFF_W2) + (size_t)l * 1024 * 4096, 4096, 1024, kb, nb, lf); }
    }
    const int gt = blockIdx.x * NTHREADS + tid, gn = gridDim.x * NTHREADS;
    for (int i = gt; i < 2 * 4 * 128 * 128 / 2; i += gn) { ((unsigned*)(p.ws + OFF_AWS))[i] = cvt_pk_bf16(p.a_ws[2 * i], p.a_ws[2 * i + 1]); }
    for (int i = gt; i < 1024; i += gn) {
        const int pos = i >> 4, f = i & 15; const float inv = powf(10000.0f, -(float)f / 16.0f); const float ang = (float)pos * inv;
        ((float*)(p.ws + OFF_ROPE))[i] = cosf(ang); ((float*)(p.ws + OFF_ROPE))[1024 + i] = sinf(ang);
    }
}

__device__ void phase_modulate0(const Params& p, bf16_t* H) {
    const float* mod = (const float*)(p.ws + OFF_MOD);
    const size_t total = (size_t)TT * 128, gn = (size_t)gridDim.x * NTHREADS;
    for (size_t i = (size_t)blockIdx.x * NTHREADS + tid_opaque(); i < total; i += gn) {
        const int row = (int)(i >> 7), c8 = (int)(i & 127) * 8;
        const float* src = (row < TL ? p.x + (size_t)row * 1024 : p.ctx + (size_t)(row - TL) * 1024) + c8;
        const int mr = row < TL ? (row >> 11) : 32;
        const float* sh = mod + (size_t)mr * 6144 + c8; const float* sc = sh + 1024;
        const f32x4 a = *(const f32x4*)src, b = *(const f32x4*)(src + 4);
        const f32x4 sa = *(const f32x4*)sh, sb = *(const f32x4*)(sh + 4), ca = *(const f32x4*)sc, cb = *(const f32x4*)(sc + 4);
        const f32x4 ya = a * (ca + 1.0f) + sa, yb = b * (cb + 1.0f) + sb;
        u32x4 w; w.x = cvt_pk_bf16(ya[0], ya[1]); w.y = cvt_pk_bf16(ya[2], ya[3]); w.z = cvt_pk_bf16(yb[0], yb[1]); w.w = cvt_pk_bf16(yb[2], yb[3]);
        *(u32x4*)(H + (size_t)row * 1024 + c8) = w;
    }
}

__device__ void phase_ln(const bf16_t* Z, int M, const float* gam, const float* bet, bf16_t* Xout, float* Dout, bf16_t* H, const float* modl  , int shoff) {
    const int tid = tid_opaque(); const int lane = tid & 63, wid = tid >> 6;
    f32x4 gv[4], bv[4];
#pragma unroll
    for (int i = 0; i < 2; ++i)
#pragma unroll
        for (int h = 0; h < 2; ++h) { gv[i * 2 + h] = *(const f32x4*)(gam + i * 512 + lane * 8 + h * 4); bv[i * 2 + h] = *(const f32x4*)(bet + i * 512 + lane * 8 + h * 4); }
    for (int row = blockIdx.x * NWAVES + wid; row < M; row += gridDim.x * NWAVES) {
        const bf16_t* zp = Z + (size_t)row * 1024 + lane * 8;
        f32x4 v[4];
#pragma unroll
        for (int i = 0; i < 2; ++i) { const u32x4 raw = *(const u32x4*)(zp + i * 512);
            v[i * 2] = (f32x4){bflo(raw.x), bfhi(raw.x), bflo(raw.y), bfhi(raw.y)}; v[i * 2 + 1] = (f32x4){bflo(raw.z), bfhi(raw.z), bflo(raw.w), bfhi(raw.w)}; }
        float s = 0.f;
#pragma unroll
        for (int i = 0; i < 4; ++i) s += (v[i][0] + v[i][1]) + (v[i][2] + v[i][3]);
#pragma unroll
        for (int o = 1; o < 64; o <<= 1) s += __shfl_xor(s, o);
        const float mean = s * (1.0f / 1024.0f);
        float q = 0.f;
#pragma unroll
        for (int i = 0; i < 4; ++i) { v[i] = v[i] - mean; q += (v[i][0] * v[i][0] + v[i][1] * v[i][1]) + (v[i][2] * v[i][2] + v[i][3] * v[i][3]); }
#pragma unroll
        for (int o = 1; o < 64; o <<= 1) q += __shfl_xor(q, o);
        const float rstd = rsqrtf(q * (1.0f / 1024.0f) + 1e-5f);
        const int mr = row < TL ? (row >> 11) : 32;
        const float* sh = modl + (size_t)mr * 6144 + shoff + lane * 8;
#pragma unroll
        for (int i = 0; i < 2; ++i) {
            const f32x4 y0 = v[i * 2] * rstd * gv[i * 2] + bv[i * 2], y1 = v[i * 2 + 1] * rstd * gv[i * 2 + 1] + bv[i * 2 + 1];
            const size_t eo = (size_t)row * 1024 + i * 512 + lane * 8;
            if (Xout) { u32x4 w; w.x = cvt_pk_bf16(y0[0], y0[1]); w.y = cvt_pk_bf16(y0[2], y0[3]); w.z = cvt_pk_bf16(y1[0], y1[1]); w.w = cvt_pk_bf16(y1[2], y1[3]); *(u32x4*)(Xout + eo) = w; }
            if (Dout && row < TL) { *(f32x4*)(Dout + eo) = y0; *(f32x4*)(Dout + eo + 4) = y1; }
            if (H) {
                const f32x4 sh0 = *(const f32x4*)(sh + i * 512), sh1 = *(const f32x4*)(sh + i * 512 + 4), sc0 = *(const f32x4*)(sh + 1024 + i * 512), sc1 = *(const f32x4*)(sh + 1024 + i * 512 + 4);
                const f32x4 h0 = y0 * (sc0 + 1.0f) + sh0, h1 = y1 * (sc1 + 1.0f) + sh1;
                u32x4 w; w.x = cvt_pk_bf16(h0[0], h0[1]); w.y = cvt_pk_bf16(h0[2], h0[3]); w.z = cvt_pk_bf16(h1[0], h1[1]); w.w = cvt_pk_bf16(h1[2], h1[3]);
                *(u32x4*)(H + eo) = w;
            }
        }
    }
}

__device__ void gmlp_unit(LAS unsigned char* lds, const bf16_t* __restrict__ P, bf16_t* __restrict__ Y, const float* lng, const float* lnb, const bf16_t* __restrict__ Aws, const float* abs_, int row0) {
    const int tid = tid_opaque(), wid = __builtin_amdgcn_readfirstlane(tid >> 6), lane = tid & 63, fr = lane & 15, fq = lane >> 4;
    LAS bf16_t* vT = (LAS bf16_t*)lds;
    {
        const int tok = tid >> 2, qd = tid & 3;
        const bf16_t* vp = P + (size_t)(row0 + tok) * 2048 + 256 + qd * 64;
        u32x4 raw[8];
#pragma unroll
        for (int i = 0; i < 8; ++i) raw[i] = *(const u32x4*)(vp + i * 8);
        float s = 0.f;
#pragma unroll
        for (int i = 0; i < 8; ++i)
#pragma unroll
            for (int e = 0; e < 4; ++e) s += bflo(raw[i][e]) + bfhi(raw[i][e]);
        s += __shfl_xor(s, 1); s += __shfl_xor(s, 2);
        const float mean = s * (1.0f / 256.0f);
        float q = 0.f;
#pragma unroll
        for (int i = 0; i < 8; ++i)
#pragma unroll
            for (int e = 0; e < 4; ++e) { const float a = bflo(raw[i][e]) - mean, b = bfhi(raw[i][e]) - mean; q += a * a + b * b; }
        q += __shfl_xor(q, 1); q += __shfl_xor(q, 2);
        const float rstd = rsqrtf(q * (1.0f / 256.0f) + 1e-5f);
#pragma unroll
        for (int i = 0; i < 8; ++i)
#pragma unroll
            for (int e = 0; e < 4; ++e) {
                const int ch = qd * 64 + i * 8 + e * 2;
                const float a = (bflo(raw[i][e]) - mean) * rstd * lng[ch] + lnb[ch];
                const float b = (bfhi(raw[i][e]) - mean) * rstd * lng[ch + 1] + lnb[ch + 1];
                const unsigned w = cvt_pk_bf16(a, b);
                vT[ch * 136 + tok] = (bf16_t)(w & 0xffffu); vT[(ch + 1) * 136 + tok] = (bf16_t)(w >> 16);
            }
    }
    __syncthreads();
    const int g = wid >> 1, ih = wid & 1;
    f32x4 acc[4][4];
#pragma unroll
    for (int a = 0; a < 4; ++a)
#pragma unroll
        for (int b = 0; b < 4; ++b) acc[a][b] = (f32x4){0.f, 0.f, 0.f, 0.f};
#pragma unroll
    for (int ks = 0; ks < 4; ++ks) {
        bf16x8 wf[4], vf[4];
#pragma unroll
        for (int it = 0; it < 4; ++it) wf[it] = *(const bf16x8*)(Aws + (size_t)((g * 128 + ih * 64 + it * 16 + fr) * 128 + ks * 32 + fq * 8));
#pragma unroll
        for (int ct = 0; ct < 4; ++ct) vf[ct] = *(const LAS bf16x8*)(vT + (g * 64 + ct * 16 + fr) * 136 + ks * 32 + fq * 8);
#pragma unroll
        for (int it = 0; it < 4; ++it)
#pragma unroll
            for (int ct = 0; ct < 4; ++ct) acc[it][ct] = __builtin_amdgcn_mfma_f32_16x16x32_bf16(vf[ct], wf[it], acc[it][ct], 0, 0, 0);
    }
#pragma unroll
    for (int it = 0; it < 4; ++it) {
        const int i = ih * 64 + it * 16 + fr; const float bias = abs_[g * 128 + i];
#pragma unroll
        for (int ct = 0; ct < 4; ++ct) {
            const int c0 = g * 64 + ct * 16 + fq * 4;
            const u32x2 uu = *(const u32x2*)(P + (size_t)(row0 + i) * 2048 + c0);
            const f32x4 a = acc[it][ct];
            u32x2 w; w.x = cvt_pk_bf16(bflo(uu.x) * (a[0] + bias), bfhi(uu.x) * (a[1] + bias)); w.y = cvt_pk_bf16(bflo(uu.y) * (a[2] + bias), bfhi(uu.y) * (a[3] + bias));
            *(u32x2*)(Y + (size_t)(row0 + i) * 1024 + c0) = w;
        }
    }
    __syncthreads();
}

struct AttnState { f32x4 o[4][4]; float m[4], l[4]; };

template <int MASK>
__device__ __forceinline__ void attn_tile(const bf16_t* __restrict__ kptr, const bf16_t* __restrict__ vtp, int vstride, const bf16x8 (&qf)[4][2], AttnState& st, int fr, int fq,
                                          int marg  , const float* __restrict__ rpbrow  ) {
    bf16x8 kf[2][2];
#pragma unroll
    for (int kt = 0; kt < 2; ++kt)
#pragma unroll
        for (int kk = 0; kk < 2; ++kk) kf[kt][kk] = *(const bf16x8*)(kptr + (size_t)(kt * 16 + fr) * 2048 + kk * 32 + fq * 8);
    bf16x8 vf[4];
#pragma unroll
    for (int dt = 0; dt < 4; ++dt) {
        const bf16_t* vp = vtp + (size_t)(dt * 16 + fr) * vstride + fq * 4;
        const bf16x4 lo = *(const bf16x4*)vp, hi = *(const bf16x4*)(vp + 16);
        vf[dt] = (bf16x8){lo[0], lo[1], lo[2], lo[3], hi[0], hi[1], hi[2], hi[3]};
    }
    f32x4 s[2][4];
#pragma unroll
    for (int kt = 0; kt < 2; ++kt)
#pragma unroll
        for (int qt = 0; qt < 4; ++qt) {
            f32x4 a = (f32x4){0.f, 0.f, 0.f, 0.f};
#pragma unroll
            for (int kk = 0; kk < 2; ++kk) a = __builtin_amdgcn_mfma_f32_16x16x32_bf16(kf[kt][kk], qf[qt][kk], a, 0, 0, 0);
            s[kt][qt] = a;
        }
    bf16x8 pf[4];
#pragma unroll
    for (int qt = 0; qt < 4; ++qt) {
        float mx = -INFINITY;
#pragma unroll
        for (int kt = 0; kt < 2; ++kt)
#pragma unroll
            for (int j = 0; j < 4; ++j) {
                float v = s[kt][qt][j];
                if (MASK == 1) {
                    const int cq = qt * 16 + fr, kc = marg + kt * 16 + fq * 4 + j;
                    int cs = cq - 8; cs = cs < 0 ? 0 : (cs > 48 ? 48 : cs);
                    const bool ok = (kc >= cs) && (kc < cs + 16);
                    const float bias = ok ? rpbrow[kc - cq + 15] : 0.f;
                    v = ok ? (v + bias) : -INFINITY;
                } else if (MASK == 2) {
                    const int d = marg + kt * 16 + fq * 4 + j - (qt * 16 + fr);
                    v = (d >= -128 && d <= 128) ? v : -INFINITY;
                }
                v *= LOG2E; s[kt][qt][j] = v; mx = fmaxf(mx, v);
            }
        mx = fmaxf(mx, __shfl_xor(mx, 16)); mx = fmaxf(mx, __shfl_xor(mx, 32));
        const float mnew = fmaxf(st.m[qt], mx);
        const float muse = (mnew == -INFINITY) ? 0.f : mnew;
        const float alpha = fexp2(st.m[qt] - muse);
        st.m[qt] = mnew;
        float ps = 0.f;
#pragma unroll
        for (int kt = 0; kt < 2; ++kt)
#pragma unroll
            for (int j = 0; j < 4; ++j) { const float pv = fexp2(s[kt][qt][j] - muse); s[kt][qt][j] = pv; ps += pv; }
        st.l[qt] = st.l[qt] * alpha + ps;
#pragma unroll
        for (int dt = 0; dt < 4; ++dt) st.o[dt][qt] = st.o[dt][qt] * alpha;
        u32x4 w; w.x = cvt_pk_bf16(s[0][qt][0], s[0][qt][1]); w.y = cvt_pk_bf16(s[0][qt][2], s[0][qt][3]); w.z = cvt_pk_bf16(s[1][qt][0], s[1][qt][1]); w.w = cvt_pk_bf16(s[1][qt][2], s[1][qt][3]);
        pf[qt] = __builtin_bit_cast(bf16x8, w);
    }
#pragma unroll
    for (int dt = 0; dt < 4; ++dt)
#pragma unroll
        for (int qt = 0; qt < 4; ++qt) st.o[dt][qt] = __builtin_amdgcn_mfma_f32_16x16x32_bf16(vf[dt], pf[qt], st.o[dt][qt], 0, 0, 0);
}

__device__ void attn_unit(const Params& p, int layer, int u, int lane) {
    const int fr = lane & 15, fq = lane >> 4;
    const bf16_t* P = (const bf16_t*)(p.ws + OFF_P);
    bf16_t* Y = (bf16_t*)(p.ws + OFF_Y);
    int mode, b, qcol, kcol, ycol, qrow0; const bf16_t* vt_l = nullptr; const bf16_t* vt_c; float sink = 0.f; bool has_sink = false;
    int r = 0, rs = 0, q0 = 0, h = 0;
    if (u < 4096) {
        mode = 0; r = u & 31; h = (u >> 5) & 3; b = u >> 7; rs = r - 4; rs = rs < 0 ? 0 : (rs > 24 ? 24 : rs);
        qrow0 = b * 2048 + r * 64; qcol = 512 + h * 64; kcol = 768 + h * 64; ycol = 256 + h * 64;
        vt_l = (const bf16_t*)(p.ws + OFF_VTNA_L) + (size_t)((b * 4 + h) * 64) * 2048; vt_c = (const bf16_t*)(p.ws + OFF_VTNA_C) + (size_t)((b * 4 + h) * 64) * 256;
    } else if (u < 12288) {
        const int v = u - 4096; mode = 1; const int qb = v & 1, g = (v >> 1) & 3, qpair = (v >> 3) & 15, kv = (v >> 7) & 1; b = v >> 8;
        const int qh = kv * 4 + g; q0 = (qpair * 2 + qb) * 64;
        qrow0 = b * 2048 + q0; qcol = 1280 + qh * 64; kcol = 1792 + kv * 64; ycol = 512 + qh * 64;
        vt_l = (const bf16_t*)(p.ws + OFF_VTSW_L) + (size_t)((b * 2 + kv) * 64) * 2048; vt_c = (const bf16_t*)(p.ws + OFF_VTSW_C) + (size_t)((b * 2 + kv) * 64) * 256;
        sink = p.sw_sink[layer * 8 + qh]; has_sink = true;
    } else {
        const int v = u - 12288; mode = 2; const int qblk = v & 3, hh = (v >> 2) % 12; b = v / 48;
        qrow0 = TL + b * 256 + qblk * 64;
        if (hh < 4) { qcol = 512 + hh * 64; kcol = 768 + hh * 64; ycol = 256 + hh * 64; vt_c = (const bf16_t*)(p.ws + OFF_VTNA_C) + (size_t)((b * 4 + hh) * 64) * 256; }
        else { const int qh = hh - 4, kv = qh >> 2; qcol = 1280 + qh * 64; kcol = 1792 + kv * 64; ycol = 512 + qh * 64; vt_c = (const bf16_t*)(p.ws + OFF_VTSW_C) + (size_t)((b * 2 + kv) * 64) * 256; sink = p.sw_sink[layer * 8 + qh]; has_sink = true; }
    }
    bf16x8 qf[4][2];
#pragma unroll
    for (int qt = 0; qt < 4; ++qt)
#pragma unroll
        for (int kk = 0; kk < 2; ++kk) qf[qt][kk] = *(const bf16x8*)(P + (size_t)(qrow0 + qt * 16 + fr) * 2048 + qcol + kk * 32 + fq * 8);
    AttnState st;
#pragma unroll
    for (int qt = 0; qt < 4; ++qt) { st.m[qt] = -INFINITY; st.l[qt] = 0.f;
#pragma unroll
        for (int dt = 0; dt < 4; ++dt) st.o[dt][qt] = (f32x4){0.f, 0.f, 0.f, 0.f}; }
    if (mode == 0) {
        const float* rpb = p.na_rpb + (size_t)((layer * 4 + h) * 15) * 31;
        for (int t = 0; t < 16; ++t) {
            const int kr = rs + (t >> 1), cbk = (t & 1) * 32, key0 = kr * 64 + cbk;
            attn_tile<1>(P + (size_t)(b * 2048 + key0) * 2048 + kcol, vt_l + key0, 2048, qf, st, fr, fq, cbk, rpb + (kr - r + 7) * 31);
        }
    } else if (mode == 1) {
        const int ks = q0 - 128 < 0 ? 0 : q0 - 128, ke = q0 + 192 > 2048 ? 2048 : q0 + 192;
        for (int key0 = ks; key0 < ke; key0 += 32)
            attn_tile<2>(P + (size_t)(b * 2048 + key0) * 2048 + kcol, vt_l + key0, 2048, qf, st, fr, fq, key0 - q0, nullptr);
    }
    for (int t = 0; t < 8; ++t)
        attn_tile<0>(P + (size_t)(TL + b * 256 + t * 32) * 2048 + kcol, vt_c + t * 32, 256, qf, st, fr, fq, 0, nullptr);
#pragma unroll
    for (int qt = 0; qt < 4; ++qt) {
        float lt = st.l[qt]; lt += __shfl_xor(lt, 16); lt += __shfl_xor(lt, 32);
        if (has_sink) lt += fexp2(sink * LOG2E - st.m[qt]);
        const float inv = 1.0f / lt;
        bf16_t* yp = Y + (size_t)(qrow0 + qt * 16 + fr) * 1024 + ycol + fq * 4;
#pragma unroll
        for (int dt = 0; dt < 4; ++dt) {
            const f32x4 o = st.o[dt][qt] * inv;
            u32x2 w; w.x = cvt_pk_bf16(o[0], o[1]); w.y = cvt_pk_bf16(o[2], o[3]);
            *(u32x2*)(yp + dt * 16) = w;
        }
    }
}

__device__ void phase_mixer(const Params& p, LAS unsigned char* lds, int layer) {
    const bf16_t* P = (const bf16_t*)(p.ws + OFF_P);
    bf16_t* Y = (bf16_t*)(p.ws + OFF_Y);
    const int nchunks = layer == 0 ? (TT / 128) : (TL / 128);
    for (int cu = blockIdx.x; cu < nchunks; cu += gridDim.x)
        gmlp_unit(lds, P, Y, p.a_ln_g + layer * 256, p.a_ln_b + layer * 256, (const bf16_t*)(p.ws + OFF_AWS) + (size_t)layer * 4 * 128 * 128, p.a_bs + layer * 512, cu * 128);
    const int tid = tid_opaque(); const int lane = tid & 63, wid = __builtin_amdgcn_readfirstlane(tid >> 6);
    const int nunits = layer == 0 ? 13824 : 12288;
    for (int u = blockIdx.x * NWAVES + wid; u < nunits; u += gridDim.x * NWAVES) attn_unit(p, layer, u, lane);
}

__device__ __forceinline__ void gsync(unsigned* bar) {
    asm volatile("s_waitcnt vmcnt(0) lgkmcnt(0)" ::: "memory");
    __syncthreads();
    if (threadIdx.x == 0) {
        __builtin_amdgcn_fence(__ATOMIC_RELEASE, "agent");
        asm volatile("s_waitcnt vmcnt(0)" ::: "memory");
        __hip_atomic_fetch_add(bar, 1u, __ATOMIC_RELAXED, __HIP_MEMORY_SCOPE_AGENT);
        while (__hip_atomic_load(bar, __ATOMIC_RELAXED, __HIP_MEMORY_SCOPE_AGENT) < gridDim.x) __builtin_amdgcn_s_sleep(2);
    }
    __syncthreads();
    __builtin_amdgcn_fence(__ATOMIC_ACQUIRE, "agent");
    asm volatile("s_waitcnt vmcnt(0) lgkmcnt(0)" ::: "memory");
}
__global__ void __launch_bounds__(NTHREADS) fwd_megakernel(Params p) {
    extern __shared__ __attribute__((aligned(16))) unsigned char lds_raw[];
    LAS unsigned char* lds = (LAS unsigned char*)lds_raw;
    cg::grid_group grid = cg::this_grid();
    if (!grid.is_valid()) return;
    bf16_t* H = (bf16_t*)(p.ws + OFF_H);
    bf16_t* XZ = (bf16_t*)(p.ws + OFF_XZ);
    const float* mod = (const float*)(p.ws + OFF_MOD);
    bf16_t* Pb = (bf16_t*)(p.ws + OFF_P); bf16_t* Yb = (bf16_t*)(p.ws + OFF_Y); bf16_t* Ub = (bf16_t*)(p.ws + OFF_U);

    phase_prologue(p, lds);
    gsync((unsigned*)(p.ws + OFF_BAR) + 0);
    phase_modulate0(p, H);
    gsync((unsigned*)(p.ws + OFF_BAR) + 1);
#pragma unroll 1
    for (int l = 0; l < 2; ++l) {
        const float* modl = mod + (size_t)l * 33 * 6144;
        const int Mres = (l == 1) ? TL : TT;
        {   EpiIn e; e.P = Pb;
            e.rcos = (const float*)(p.ws + OFF_ROPE); e.rsin = e.rcos + 1024;
            gemm_phase(lds, H, (const bf16_t*)(p.ws + OFF_WIN) + (size_t)l * 2048 * 1024, TT, 2048, 1024, e); }
        gsync((unsigned*)(p.ws + OFF_BAR) + 2 + l * 8);
        phase_vtrans(p, lds);
        gsync((unsigned*)(p.ws + OFF_BAR) + 9 + l * 8);
        phase_mixer(p, lds, l);
        gsync((unsigned*)(p.ws + OFF_BAR) + 3 + l * 8);
        {   EpiRes e; e.res_lat = p.x; e.res_ctx = p.ctx; e.resb = (l == 0) ? nullptr : XZ; e.g = modl + 2048; e.out = XZ;
            gemm_phase(lds, Yb, (const bf16_t*)(p.ws + OFF_WOUT) + (size_t)l * 1024 * 1024, Mres, 1024, 1024, e); }
        gsync((unsigned*)(p.ws + OFF_BAR) + 4 + l * 8);
        phase_ln(XZ, Mres, p.ln1_g + l * 1024, p.ln1_b + l * 1024, XZ, nullptr, H, modl, 3072);
        gsync((unsigned*)(p.ws + OFF_BAR) + 5 + l * 8);
        {   EpiRelu2 e; e.U = Ub;
            gemm_phase(lds, H, (const bf16_t*)(p.ws + OFF_W1) + (size_t)l * 4096 * 1024, Mres, 4096, 1024, e); }
        gsync((unsigned*)(p.ws + OFF_BAR) + 6 + l * 8);
        {   EpiRes e; e.res_lat = p.x; e.res_ctx = p.ctx; e.resb = XZ; e.g = modl + 5120; e.out = XZ;
            gemm_phase(lds, Ub, (const bf16_t*)(p.ws + OFF_W2) + (size_t)l * 1024 * 4096, Mres, 1024, 4096, e); }
        gsync((unsigned*)(p.ws + OFF_BAR) + 7 + l * 8);
        if (l == 0) { phase_ln(XZ, Mres, p.ln2_g, p.ln2_b, XZ, nullptr, H, mod + (size_t)33 * 6144, 0); gsync((unsigned*)(p.ws + OFF_BAR) + 8 + l * 8); }
        else phase_ln(XZ, Mres, p.ln2_g + 1024, p.ln2_b + 1024, nullptr, p.out, nullptr, modl, 0);
    }
}

extern "C" void kernel_launch(void* const* d_in, const int* in_sizes, int n_in, void* d_out, int out_size, void* d_ws, size_t ws_size, hipStream_t stream) {
    static int grid_blocks = 0;
    if (grid_blocks == 0) {
        if (n_in != 20 || out_size != TL * DM || ws_size < WS_END) { fprintf(stderr, "kernel_launch: unexpected shapes (n_in %d, out %d, ws %zu, need %zu)\n", n_in, out_size, ws_size, (size_t)WS_END); grid_blocks = -1; return; }
        int dev = 0, cus = 0, per_cu = 0;
        hipGetDevice(&dev);
        hipDeviceGetAttribute(&cus, hipDeviceAttributeMultiprocessorCount, dev);
        if (hipFuncSetAttribute((const void*)fwd_megakernel, hipFuncAttributeMaxDynamicSharedMemorySize, LDS_BYTES) != hipSuccess) { fprintf(stderr, "kernel_launch: hipFuncSetAttribute failed\n"); grid_blocks = -1; return; }
        if (hipOccupancyMaxActiveBlocksPerMultiprocessor(&per_cu, (const void*)fwd_megakernel, NTHREADS, LDS_BYTES) != hipSuccess || per_cu < 1) { fprintf(stderr, "kernel_launch: occupancy query gave %d\n", per_cu); per_cu = 1; }
        (void)hipGetLastError();
        grid_blocks = cus * per_cu;
    }
    if (grid_blocks < 0) return;
    Params p{};
    const float** f = (const float**)&p;
    for (int i = 0; i < 20; ++i) f[i] = (const float*)d_in[i];
    p.out = (float*)d_out; p.ws = (unsigned char*)d_ws;
    if (hipMemsetAsync((unsigned char*)d_ws + OFF_BAR, 0, 256, stream) != hipSuccess) { fprintf(stderr, "kernel_launch: memset failed\n"); return; }
    void* args[] = {&p};
    hipError_t e = hipLaunchCooperativeKernel((const void*)fwd_megakernel, dim3(grid_blocks), dim3(NTHREADS), args, LDS_BYTES, stream);
    if (e != hipSuccess) fprintf(stderr, "cooperative launch failed: %s (grid %d)\n", hipGetErrorString(e), grid_blocks);
}
```
